# Optimizing an MI355X kernel written in HIP

```python
import jax, jax.numpy as jnp
from jax import lax
import numpy as np

D_MODEL = 2048
BATCH = 1
SEQ = 16384
DEPTH = 1

CHUNK = 64
Q_BLOCK = 128
ROPE_THETA = 500000.0
ROPE_FRACTION = 4
NORM_EPS = 1e-6

ATTN_HEAD_DIM = 128
ATTN_WIDTH = D_MODEL // 2
ATTN_HEADS = ATTN_WIDTH // ATTN_HEAD_DIM
ATTN_KV_HEADS = max(1, ATTN_HEADS // 4)
KV_WIDTH = ATTN_KV_HEADS * ATTN_HEAD_DIM
IDX_HEADS = 8
IDX_HEAD_DIM = 64
TOPK_MAX = 256

RWKV_HEAD_DIM = 64
RWKV_WIDTH = D_MODEL - ATTN_WIDTH
RWKV_HEADS = RWKV_WIDTH // RWKV_HEAD_DIM
DECAY_LORA = 64
ICLR_LORA = 64
GATE_LORA = 64
GN_EPS = 64e-5

MIX_WIDTH = ATTN_WIDTH + RWKV_WIDTH
D_FF = 5632

PROJ_SPLITS = (ATTN_WIDTH, KV_WIDTH, KV_WIDTH,
               IDX_HEADS * IDX_HEAD_DIM, IDX_HEAD_DIM, IDX_HEADS,
               RWKV_WIDTH, RWKV_WIDTH, RWKV_WIDTH,
               DECAY_LORA, ICLR_LORA, GATE_LORA)
PROJ_WIDTH = sum(PROJ_SPLITS)

kernel_name = 'hymba_dsa_rwkv7_macaron_block'


def rms_norm(x, g):
    x32 = x.astype(jnp.float32)
    y = x32 * lax.rsqrt(jnp.mean(x32 * x32, axis=-1, keepdims=True) + NORM_EPS)
    return (y * g.astype(jnp.float32)).astype(x.dtype)


def swiglu(x, w_gate, w_up, w_down):
    return (jax.nn.silu(x @ w_gate) * (x @ w_up)) @ w_down


def rope_partial(x, pos):
    dh = x.shape[-1]
    rot = dh // ROPE_FRACTION
    half = rot // 2
    inv_freq = ROPE_THETA ** (-(jnp.arange(half, dtype=jnp.float32) * 2.0 / rot))
    ang = pos.astype(jnp.float32)[:, None] * inv_freq[None, :]
    cos = jnp.cos(ang)[None, :, None, :]
    sin = jnp.sin(ang)[None, :, None, :]
    x32 = x.astype(jnp.float32)
    x1, x2, rest = x32[..., :half], x32[..., half:rot], x32[..., rot:]
    out = jnp.concatenate([x1 * cos - x2 * sin, x2 * cos + x1 * sin, rest], axis=-1)
    return out.astype(x.dtype)


def split_columns(u):
    idx = [int(v) for v in np.cumsum(PROJ_SPLITS)[:-1]]
    return jnp.split(u, idx, axis=-1)


def dsa_attention(q, k, v, qi, ki, wi):
    B, S = q.shape[0], q.shape[1]
    G, R, Dh = ATTN_KV_HEADS, ATTN_HEADS // ATTN_KV_HEADS, ATTN_HEAD_DIM
    k_sel = min(TOPK_MAX, S // 4)
    nblk = S // Q_BLOCK
    key_chunk = jnp.arange(S) // CHUNK
    idx_scale = (IDX_HEADS ** -0.5) * (IDX_HEAD_DIM ** -0.5)
    att_scale = Dh ** -0.5
    ki32 = ki.astype(jnp.float32)

    def to_blocks(a):
        return jnp.moveaxis(a.reshape((B, nblk, Q_BLOCK) + a.shape[2:]), 1, 0)

    qb = to_blocks(q.reshape(B, S, G, R, Dh))
    qib = to_blocks(qi)
    wib = to_blocks(wi)
    tb = jnp.arange(S).reshape(nblk, Q_BLOCK)

    def block(args):
        q_blk, qi_blk, wi_blk, t_blk = args
        s_idx = jnp.einsum('bqhd,bsd->bqhs', qi_blk.astype(jnp.float32), ki32)
        score = jnp.einsum('bqh,bqhs->bqs', wi_blk.astype(jnp.float32) * idx_scale,
                           jax.nn.relu(s_idx))
        q_chunk = t_blk // CHUNK
        admissible = key_chunk[None, :] <= q_chunk[:, None]
        score = jnp.where(admissible[None], score, -jnp.inf)
        _, sel = lax.top_k(score, k_sel)
        valid = (sel // CHUNK) <= q_chunk[None, :, None]
        k_g = jax.vmap(lambda kb, ib: kb[ib])(k, sel)
        v_g = jax.vmap(lambda vb, ib: vb[ib])(v, sel)
        s = jnp.einsum('bqgrd,bqngd->bqgrn', q_blk.astype(jnp.float32),
                       k_g.astype(jnp.float32)) * att_scale
        s = jnp.where(valid[:, :, None, None, :], s, -jnp.inf)
        p = jax.nn.softmax(s, axis=-1)
        o = jnp.einsum('bqgrn,bqngd->bqgrd', p, v_g.astype(jnp.float32))
        return o.astype(q.dtype)

    out = lax.map(block, (qb, qib, wib, tb))
    return jnp.moveaxis(out, 0, 1).reshape(B, S, ATTN_WIDTH)


def token_shift_lerp(p, mu):
    prev = jnp.pad(p, ((0, 0), (1, 0), (0, 0)))[:, :-1]
    return p + (prev - p) * mu


def rwkv7_time_mix(r_p, k_p, v_p, wd_p, ad_p, gd_p, mu_r, mu_k, mu_v, mu_w, mu_a, mu_g,
                   w0, w2, a0, a2, g2, k_k, k_a, r_k, gn_gain, gn_bias):
    B, S = r_p.shape[0], r_p.shape[1]
    H, N = RWKV_HEADS, RWKV_HEAD_DIM
    dt = r_p.dtype
    r = token_shift_lerp(r_p, mu_r)
    k = token_shift_lerp(k_p, mu_k)
    v = token_shift_lerp(v_p, mu_v)
    xw = token_shift_lerp(wd_p, mu_w)
    xa = token_shift_lerp(ad_p, mu_a)
    xg = token_shift_lerp(gd_p, mu_g)

    w = -jax.nn.softplus(-(w0 + jnp.tanh(xw) @ w2)) - 0.5
    decay = jnp.exp(-jnp.exp(w.astype(jnp.float32)))
    a = jax.nn.sigmoid((a0 + xa @ a2).astype(jnp.float32))
    g = jax.nn.sigmoid(xg) @ g2

    hd = lambda t: t.reshape(B, S, H, N).astype(jnp.float32)
    r, k, v, a, decay = hd(r), hd(k), hd(v), hd(a), hd(decay)
    kk = k * k_k.reshape(H, N).astype(jnp.float32)
    kk = kk / jnp.maximum(jnp.sqrt(jnp.sum(kk * kk, axis=-1, keepdims=True)), 1e-12)
    k = k * (1.0 + (a - 1.0) * k_a.reshape(H, N).astype(jnp.float32))

    def step(state, xs):
        r_t, w_t, k_t, v_t, a_t, b_t = xs
        sa = jnp.einsum('bhvk,bhk->bhv', state, a_t)
        state = (state * w_t[:, :, None, :] + sa[..., None] * b_t[:, :, None, :]
                 + v_t[..., None] * k_t[:, :, None, :])
        y_t = jnp.einsum('bhvk,bhk->bhv', state, r_t)
        return state, y_t

    tf = lambda t: jnp.moveaxis(t, 1, 0)
    state0 = jnp.zeros((B, H, N, N), jnp.float32)
    _, y = lax.scan(step, state0, (tf(r), tf(decay), tf(k), tf(v), tf(-kk), tf(kk * a)))
    y = jnp.moveaxis(y, 0, 1)

    mean = jnp.mean(y, axis=-1, keepdims=True)
    var = jnp.mean(jnp.square(y - mean), axis=-1, keepdims=True)
    y = ((y - mean) * lax.rsqrt(var + GN_EPS)).reshape(B, S, RWKV_WIDTH)
    y = y * gn_gain.astype(jnp.float32) + gn_bias.astype(jnp.float32)
    bonus = jnp.sum(r * k * r_k.astype(jnp.float32), axis=-1, keepdims=True) * v
    y = y + bonus.reshape(B, S, RWKV_WIDTH)
    return (y * g.astype(jnp.float32)).astype(dt)


def setup_inputs(seed: int = 0) -> dict:
    key = jax.random.key(seed)
    ks = iter(jax.random.split(key, 40))
    L, D, F = DEPTH, D_MODEL, D_FF
    nrm = lambda shape, scale: jax.random.normal(next(ks), shape, jnp.float32) * scale
    gain = lambda shape: 1.0 + nrm(shape, 0.02)
    unif = lambda shape, lo, hi: jax.random.uniform(next(ks), shape, jnp.float32, lo, hi)
    return {
        'x': nrm((BATCH, SEQ, D), 1.0),
        'ffn1_norm': gain((L, D)),
        'ffn1_w_gate': nrm((L, D, F), D ** -0.5),
        'ffn1_w_up': nrm((L, D, F), D ** -0.5),
        'ffn1_w_down': nrm((L, F, D), F ** -0.5),
        'mix_norm': gain((L, D)),
        'w_in': nrm((L, D, PROJ_WIDTH), D ** -0.5),
        'w_out': nrm((L, MIX_WIDTH, D), MIX_WIDTH ** -0.5),
        'rwkv_mu_r': unif((L, RWKV_WIDTH), 0.0, 1.0),
        'rwkv_mu_k': unif((L, RWKV_WIDTH), 0.0, 1.0),
        'rwkv_mu_v': unif((L, RWKV_WIDTH), 0.0, 1.0),
        'rwkv_mu_w': unif((L, DECAY_LORA), 0.0, 1.0),
        'rwkv_mu_a': unif((L, ICLR_LORA), 0.0, 1.0),
        'rwkv_mu_g': unif((L, GATE_LORA), 0.0, 1.0),
        'rwkv_w0': unif((L, RWKV_WIDTH), -6.5, -1.5),
        'rwkv_w2': nrm((L, DECAY_LORA, RWKV_WIDTH), 0.1 * DECAY_LORA ** -0.5),
        'rwkv_a0': nrm((L, RWKV_WIDTH), 0.1),
        'rwkv_a2': nrm((L, ICLR_LORA, RWKV_WIDTH), 0.1 * ICLR_LORA ** -0.5),
        'rwkv_g2': nrm((L, GATE_LORA, RWKV_WIDTH), GATE_LORA ** -0.5),
        'rwkv_k_k': 0.85 + nrm((L, RWKV_WIDTH), 0.02),
        'rwkv_k_a': gain((L, RWKV_WIDTH)),
        'rwkv_r_k': nrm((L, RWKV_HEADS, RWKV_HEAD_DIM), 0.1),
        'rwkv_gn_gain': gain((L, RWKV_WIDTH)),
        'rwkv_gn_bias': nrm((L, RWKV_WIDTH), 0.02),
        'ffn2_norm': gain((L, D)),
        'ffn2_w_gate': nrm((L, D, F), D ** -0.5),
        'ffn2_w_up': nrm((L, D, F), D ** -0.5),
        'ffn2_w_down': nrm((L, F, D), F ** -0.5),
        'final_norm': gain((D,)),
    }


def reference(x, ffn1_norm, ffn1_w_gate, ffn1_w_up, ffn1_w_down, mix_norm, w_in, w_out,
              rwkv_mu_r, rwkv_mu_k, rwkv_mu_v, rwkv_mu_w, rwkv_mu_a, rwkv_mu_g,
              rwkv_w0, rwkv_w2, rwkv_a0, rwkv_a2, rwkv_g2, rwkv_k_k, rwkv_k_a, rwkv_r_k,
              rwkv_gn_gain, rwkv_gn_bias, ffn2_norm, ffn2_w_gate, ffn2_w_up, ffn2_w_down,
              final_norm):
    B, S, _ = x.shape
    pos = jnp.arange(S)
    h = x
    for l in range(DEPTH):
        h = h + 0.5 * swiglu(rms_norm(h, ffn1_norm[l]), ffn1_w_gate[l], ffn1_w_up[l], ffn1_w_down[l])

        u = rms_norm(h, mix_norm[l]) @ w_in[l]
        q, k, v, qi, ki, wi, rr, rk, rv, wd, ad, gd = split_columns(u)

        q = rope_partial(q.reshape(B, S, ATTN_HEADS, ATTN_HEAD_DIM), pos)
        k = rope_partial(k.reshape(B, S, ATTN_KV_HEADS, ATTN_HEAD_DIM), pos)
        v = v.reshape(B, S, ATTN_KV_HEADS, ATTN_HEAD_DIM)
        qi = rope_partial(qi.reshape(B, S, IDX_HEADS, IDX_HEAD_DIM), pos)
        ki = rope_partial(ki.reshape(B, S, 1, IDX_HEAD_DIM), pos)[:, :, 0]
        attn_out = dsa_attention(q, k, v, qi, ki, wi)

        rwkv_out = rwkv7_time_mix(rr, rk, rv, wd, ad, gd,
                                  rwkv_mu_r[l], rwkv_mu_k[l], rwkv_mu_v[l],
                                  rwkv_mu_w[l], rwkv_mu_a[l], rwkv_mu_g[l],
                                  rwkv_w0[l], rwkv_w2[l], rwkv_a0[l], rwkv_a2[l], rwkv_g2[l],
                                  rwkv_k_k[l], rwkv_k_a[l], rwkv_r_k[l],
                                  rwkv_gn_gain[l], rwkv_gn_bias[l])

        h = h + jnp.concatenate([attn_out, rwkv_out], axis=-1) @ w_out[l]

        h = h + 0.5 * swiglu(rms_norm(h, ffn2_norm[l]), ffn2_w_gate[l], ffn2_w_up[l], ffn2_w_down[l])
    return rms_norm(h, final_norm)
```

```cpp
#include <hip/hip_runtime.h>
#include <hip/hip_cooperative_groups.h>
#include <cstdio>
#include <cstdint>
#include <cmath>
namespace cg = cooperative_groups;

#define LAS __attribute__((address_space(3)))
typedef unsigned short bf16_t;
typedef short bf16x8 __attribute__((ext_vector_type(8)));
typedef float f32x4 __attribute__((ext_vector_type(4)));
typedef float f32x2 __attribute__((ext_vector_type(2)));
typedef float f32x16 __attribute__((ext_vector_type(16)));
typedef unsigned u32x4 __attribute__((ext_vector_type(4)));
typedef unsigned u32x2 __attribute__((ext_vector_type(2)));

constexpr int S = 16384, DM = 2048, FF = 5632, PW = 5384, PWP = 5632;
constexpr int NTHR = 512, NWAVES = 8;
constexpr int URR = 0, URK = 1024, URV = 2048, UWD = 3072, UAD = 3136, UGD = 3200, NG1 = 3328, UQ = 3328, UK = 4352, UV = 4608, UQI = 4864, UKI = 5376, UWI = 5440, NG2 = 2304;
static_assert(NG1 + NG2 == 5632, "in-proj column groups");
constexpr float NORM_EPS = 1e-6f, GN_EPS = 64e-5f;
constexpr size_t MiB = 1u << 20;
constexpr size_t WS_U = 0;
constexpr size_t WS_XN = 176 * MiB;
constexpr size_t WS_WB = 240 * MiB;
constexpr size_t WS_WB2 = 284 * MiB;
constexpr size_t WS_R = 240 * MiB, WS_V = 272 * MiB;
constexpr size_t WS_W = 306 * MiB;
constexpr size_t WS_A = 370 * MiB, WS_B = 402 * MiB, WS_KP = 434 * MiB;
constexpr size_t WS_WOUT = 466 * MiB;
constexpr size_t WS_BR = 474 * MiB, WS_KR = 475 * MiB, WS_BON = 476 * MiB;
constexpr size_t WS_CTL = 477 * MiB;
constexpr size_t WS_KI2 = 478 * MiB;
constexpr size_t WS_KV2 = 480 * MiB;
constexpr size_t WS_WIN2 = 496 * MiB;
constexpr size_t WS_END = 506 * MiB;
constexpr int LDS_BYTES = 163840;

__device__ __forceinline__ unsigned f2bf(float f) { unsigned u = __builtin_bit_cast(unsigned, f); return (u + 0x7fffu + ((u >> 16) & 1u)) >> 16; }
__device__ __forceinline__ unsigned pk2(float lo, float hi) { return f2bf(lo) | (f2bf(hi) << 16); }
__device__ __forceinline__ float bf2f(unsigned b) { return __builtin_bit_cast(float, b << 16); }
__device__ __forceinline__ float bflo(unsigned p) { return __builtin_bit_cast(float, p << 16); }
__device__ __forceinline__ float bfhi(unsigned p) { return __builtin_bit_cast(float, p & 0xffff0000u); }
template <int CTRL> __device__ __forceinline__ float dppf(float v) {
    return __builtin_bit_cast(float, __builtin_amdgcn_update_dpp(0, __builtin_bit_cast(int, v), CTRL, 0xF, 0xF, false));
}
__device__ __forceinline__ float red16(float v) {
    v += dppf<0xB1>(v); v += dppf<0x4E>(v); v += dppf<0x141>(v); v += dppf<0x140>(v); return v;
}

template <int CTRL, int ROWMASK> __device__ __forceinline__ float dppf_m(float oldv, float v) {
    return __builtin_bit_cast(float, __builtin_amdgcn_update_dpp(__builtin_bit_cast(int, oldv), __builtin_bit_cast(int, v), CTRL, ROWMASK, 0xF, false));
}
__device__ __forceinline__ float wave_sum(float v) {
    v += dppf<0xB1>(v); v += dppf<0x4E>(v); v += dppf<0x141>(v); v += dppf<0x140>(v);
    v += dppf_m<0x142, 0xA>(0.f, v);
    v += dppf_m<0x143, 0xC>(0.f, v);
    return __builtin_bit_cast(float, __builtin_amdgcn_readlane(__builtin_bit_cast(int, v), 63));
}
__device__ __forceinline__ float wave_max(float v) {
    v = fmaxf(v, dppf<0xB1>(v)); v = fmaxf(v, dppf<0x4E>(v)); v = fmaxf(v, dppf<0x141>(v)); v = fmaxf(v, dppf<0x140>(v));
    v = fmaxf(v, dppf_m<0x142, 0xA>(v, v));
    v = fmaxf(v, dppf_m<0x143, 0xC>(v, v));
    return __builtin_bit_cast(float, __builtin_amdgcn_readlane(__builtin_bit_cast(int, v), 63));
}
namespace pg8 {
constexpr int BM = 256, BK = 64, HALF = 128, HTB = HALF * BK * 2, STAGE_BYTES = 8 * HTB, NXCD = 8, WGM = 4;
__host__ __device__ __forceinline__ int lds_byte(int r, int c) { const int st = (r >> 4) * 2 + (c >> 5), rr = r & 15, cc = c & 31, ob = rr * 64 + cc * 2; return st * 1024 + (ob ^ (((ob >> 9) & 1) << 5)); }
__host__ __device__ __forceinline__ void stage_rc(int b, int& R, int& C) { const int st = b / 1024, sb = b % 1024, swz = sb ^ (((sb >> 9) & 1) << 5); R = (st >> 1) * 16 + swz / 64; C = (st & 1) * 32 + (swz % 64) / 2; }
__host__ __device__ __forceinline__ int perm32(int rho) { const int n = rho >> 4, i = rho & 15; return 8 * (i >> 2) + 4 * n + (i & 3); }
struct Unit { int pm, pn; };
struct Gemm { const bf16_t* A; const bf16_t* Bt; int M, N, K; };
struct StaticOrder {
    int nM, nN, nwg, G, c;
    __host__ __device__ void init(int M, int N, int G_, int c_) { nM = M / BM; nN = N / BM; nwg = nM * nN; G = G_; c = c_; }
    __host__ __device__ bool next(int i, Unit& u) const {
        const long L = (long)i * G + c; if (L >= nwg) return false;
        int wgid = (int)L; { const int q = nwg / NXCD, r = nwg % NXCD, xcd = wgid % NXCD, off = wgid / NXCD; wgid = (xcd < r ? xcd * (q + 1) : r * (q + 1) + (xcd - r) * q) + off; }
        const int nig = WGM * nN, gid = wgid / nig, fm = gid * WGM, gsz = (nM - fm) < WGM ? (nM - fm) : WGM;
        u.pm = fm + ((wgid % nig) % gsz); u.pn = (wgid % nig) / gsz; return true;
    }
};
__device__ __forceinline__ unsigned cvt_pk_bf16(float lo, float hi) { unsigned r; asm volatile("v_cvt_pk_bf16_f32 %0, %1, %2" : "=v"(r) : "v"(lo), "v"(hi)); return r; }

struct EpiBf16 {
    bf16_t* O; int ldc;
    __device__ __forceinline__ void operator()(const f32x4 (&acc)[2][2][4][2], const Unit& u, int wr, int wc, int fr, int fq) const {
        const int row0 = u.pm * BM + wr * 64 + fr, col0 = u.pn * BM + wc * 32 + 8 * fq;
#pragma unroll
        for (int ai = 0; ai < 2; ++ai)
#pragma unroll
            for (int m = 0; m < 4; ++m) { bf16_t* rowp = O + (size_t)(row0 + ai * HALF + m * 16) * ldc + col0;
#pragma unroll
                for (int bj = 0; bj < 2; ++bj) { const f32x4 v0 = acc[ai][bj][m][0], v1 = acc[ai][bj][m][1];
                    u32x4 w; w.x = cvt_pk_bf16(v0[0], v0[1]); w.y = cvt_pk_bf16(v0[2], v0[3]); w.z = cvt_pk_bf16(v1[0], v1[1]); w.w = cvt_pk_bf16(v1[2], v1[3]);
                    *(u32x4*)(rowp + bj * HALF) = w; } }
    }
};
struct EpiSwiglu {
    bf16_t* O; int ldc;
    __device__ __forceinline__ void operator()(const f32x4 (&acc)[2][2][4][2], const Unit& u, int wr, int wc, int fr, int fq) const {
        const int row0 = u.pm * BM + wr * 64 + fr, col0 = (u.pn * BM + wc * 32) / 2 + 4 * fq;
#pragma unroll
        for (int ai = 0; ai < 2; ++ai)
#pragma unroll
            for (int m = 0; m < 4; ++m) { bf16_t* rowp = O + (size_t)(row0 + ai * HALF + m * 16) * ldc + col0;
#pragma unroll
                for (int bj = 0; bj < 2; ++bj) { const f32x4 g = acc[ai][bj][m][0], up = acc[ai][bj][m][1];
                    float a[4];
#pragma unroll
                    for (int e = 0; e < 4; ++e) a[e] = g[e] * __builtin_amdgcn_rcpf(1.f + __expf(-g[e])) * up[e];
                    u32x2 w; w.x = cvt_pk_bf16(a[0], a[1]); w.y = cvt_pk_bf16(a[2], a[3]);
                    *(u32x2*)(rowp + bj * (HALF / 2)) = w; } }
    }
};
struct EpiResF32 {
    const float* base; float* out; int ldc; float scale;
    __device__ __forceinline__ void operator()(const f32x4 (&acc)[2][2][4][2], const Unit& u, int wr, int wc, int fr, int fq) const {
        const int row0 = u.pm * BM + wr * 64 + fr, col0 = u.pn * BM + wc * 32 + 8 * fq;
#pragma unroll
        for (int ai = 0; ai < 2; ++ai)
#pragma unroll
            for (int m = 0; m < 4; ++m) { const size_t ro = (size_t)(row0 + ai * HALF + m * 16) * ldc + col0;
#pragma unroll
                for (int bj = 0; bj < 2; ++bj) {
                    const f32x4 b0 = *(const f32x4*)(base + ro + bj * HALF), b1 = *(const f32x4*)(base + ro + bj * HALF + 4);
                    *(f32x4*)(out + ro + bj * HALF) = b0 + acc[ai][bj][m][0] * scale;
                    *(f32x4*)(out + ro + bj * HALF + 4) = b1 + acc[ai][bj][m][1] * scale; } }
    }
};

#ifndef PG8_SP2
#define PG8_SP2 false
#endif
template <class Epi, class Sched, bool SP2 = PG8_SP2>
__device__ __forceinline__ void gemm_phase(LAS unsigned char* lds, const Gemm g, const Sched& S, const Epi& E) {
    const int tid = threadIdx.x, wid = __builtin_amdgcn_readfirstlane(tid >> 6), lane = tid & 63, wr = wid >> 2, wc = wid & 3, fr = lane & 15, fq = lane >> 4;
    const int K = g.K, nt = K / BK;
    unsigned voffA[2], voffB[2];
#pragma unroll
    for (int i = 0; i < 2; ++i) { int R, C; stage_rc(tid * 16 + i * 8192, R, C); const int Rb = (R & ~31) + perm32(R & 31);
        voffA[i] = (unsigned)(R * K + C) * 2u; voffB[i] = (unsigned)(Rb * K + C) * 2u; }
    const size_t kstep = (size_t)(BK * 2);
    const size_t hstep = (size_t)HALF * K * 2;
    const size_t tstep = 2 * hstep;
    const unsigned ldsw = (unsigned)wid * 1024u;
    const int aoff = lds_byte(wr * 64 + fr, fq * 8), boff = lds_byte(wc * 32 + fr, fq * 8);
#define PG8_SA(b, h) (((b) * 2 + (h)) * HTB)
#define PG8_SB(b, h) ((4 + (b) * 2 + (h)) * HTB)
#define PG8_STAGE(bufoff, gbase, voff) do { _Pragma("unroll") for (int _i = 0; _i < 2; ++_i) \
        __builtin_amdgcn_global_load_lds((const unsigned*)((const char*)(gbase) + (voff)[_i]), (LAS unsigned*)(lds + (bufoff) + ldsw + _i * 8192), 16, 0, 0); } while (0)
#define PG8_LDA(dst, b, h) do { _Pragma("unroll") for (int m = 0; m < 4; ++m) _Pragma("unroll") for (int k = 0; k < 2; ++k) dst[m][k] = *(const LAS bf16x8*)(lds + PG8_SA(b, h) + aoff + m * 2048 + k * 1024); } while (0)
#define PG8_LDB(dst, b, h) do { _Pragma("unroll") for (int n = 0; n < 2; ++n) _Pragma("unroll") for (int k = 0; k < 2; ++k) dst[n][k] = *(const LAS bf16x8*)(lds + PG8_SB(b, h) + boff + n * 2048 + k * 1024); } while (0)
#define PG8_MMA(ai, bj, At, Bt) do { __builtin_amdgcn_s_setprio(1); _Pragma("unroll") for (int m = 0; m < 4; ++m) _Pragma("unroll") for (int n = 0; n < 2; ++n) _Pragma("unroll") for (int k = 0; k < 2; ++k) \
        acc[ai][bj][m][n] = __builtin_amdgcn_mfma_f32_16x16x32_bf16(Bt[n][k], At[m][k], acc[ai][bj][m][n], 0, 0, 0); __builtin_amdgcn_s_setprio(0); } while (0)
#define PG8_WAIT_V(n) asm volatile("s_waitcnt vmcnt(" #n ")" ::: "memory")
#define PG8_WAIT_L(n) asm volatile("s_waitcnt lgkmcnt(" #n ")" ::: "memory")
#define PG8_BAR __builtin_amdgcn_s_barrier()
#define PG8_SCHED __builtin_amdgcn_sched_barrier(0)
    Unit cur, nxt; int ui = 0;
    if (!S.next(0, cur)) return;
    f32x4 acc[2][2][4][2];
#pragma unroll
    for (int a = 0; a < 2; ++a)
#pragma unroll
        for (int b = 0; b < 2; ++b)
#pragma unroll
            for (int m = 0; m < 4; ++m)
#pragma unroll
                for (int n = 0; n < 2; ++n) acc[a][b][m][n] = (f32x4){0.f, 0.f, 0.f, 0.f};
    bf16x8 At[4][2], B0[2][2], B1[2][2];
    const char* cA = (const char*)g.A + (size_t)cur.pm * tstep; const char* cB = (const char*)g.Bt + (size_t)cur.pn * tstep;
    if constexpr (SP2) {
    PG8_STAGE(PG8_SB(0, 0), cB, voffB); PG8_STAGE(PG8_SB(0, 1), cB + hstep, voffB); PG8_STAGE(PG8_SA(0, 0), cA, voffA); PG8_STAGE(PG8_SA(0, 1), cA + hstep, voffA);
    if (wr == 1) PG8_BAR;
    PG8_WAIT_V(2); PG8_BAR;
    PG8_STAGE(PG8_SB(1, 0), cB + kstep, voffB); PG8_STAGE(PG8_SA(1, 0), cA + kstep, voffA); PG8_STAGE(PG8_SB(1, 1), cB + hstep + kstep, voffB);
    PG8_WAIT_V(6); PG8_BAR;
    } else {
    PG8_STAGE(PG8_SB(0, 0), cB, voffB); PG8_STAGE(PG8_SA(0, 0), cA, voffA); PG8_STAGE(PG8_SB(0, 1), cB + hstep, voffB); PG8_STAGE(PG8_SA(0, 1), cA + hstep, voffA);
    if (wr == 1) PG8_BAR;
    PG8_WAIT_V(4); PG8_BAR;
    PG8_STAGE(PG8_SB(1, 0), cB + kstep, voffB); PG8_STAGE(PG8_SA(1, 0), cA + kstep, voffA); PG8_STAGE(PG8_SB(1, 1), cB + hstep + kstep, voffB);
    PG8_WAIT_V(6); PG8_BAR;
    }
    for (;;) {
        const bool has_next = S.next(ui + 1, nxt);
        const char* nA = has_next ? (const char*)g.A + (size_t)nxt.pm * tstep : cA; const char* nB = has_next ? (const char*)g.Bt + (size_t)nxt.pn * tstep : cB;
        for (int t = 0; t < nt; t += 2) {
            const bool last = (t == nt - 2);
            const char* a1 = cA + (size_t)(t + 1) * kstep;
            const char* a2 = last ? nA : cA + (size_t)(t + 2) * kstep; const char* b2 = last ? nB : cB + (size_t)(t + 2) * kstep;
            const char* a3 = a2 + kstep; const char* b3 = b2 + kstep;
            if constexpr (SP2) {
            PG8_LDB(B0, 0, 0); PG8_LDB(B1, 0, 1); PG8_SCHED; PG8_LDA(At, 0, 0); PG8_STAGE(PG8_SA(1, 1), a1 + hstep, voffA);
            PG8_WAIT_V(8); PG8_WAIT_L(0); PG8_BAR; PG8_MMA(0, 0, At, B0); PG8_MMA(0, 1, At, B1); PG8_BAR; PG8_SCHED;
            PG8_LDA(At, 0, 1); PG8_STAGE(PG8_SB(0, 0), b2, voffB); PG8_STAGE(PG8_SB(0, 1), b2 + hstep, voffB); PG8_STAGE(PG8_SA(0, 0), a2, voffA);
            PG8_WAIT_V(8); PG8_WAIT_L(0); PG8_BAR; PG8_MMA(1, 0, At, B0); PG8_MMA(1, 1, At, B1); PG8_BAR; PG8_SCHED;
            PG8_LDB(B0, 1, 0); PG8_LDB(B1, 1, 1); PG8_SCHED; PG8_LDA(At, 1, 0); PG8_STAGE(PG8_SA(0, 1), a2 + hstep, voffA);
            PG8_WAIT_V(8); PG8_WAIT_L(0); PG8_BAR; PG8_MMA(0, 0, At, B0); PG8_MMA(0, 1, At, B1); PG8_BAR; PG8_SCHED;
            PG8_LDA(At, 1, 1); PG8_STAGE(PG8_SB(1, 0), b3, voffB); PG8_STAGE(PG8_SB(1, 1), b3 + hstep, voffB); PG8_STAGE(PG8_SA(1, 0), a3, voffA);
            PG8_WAIT_V(8); PG8_WAIT_L(0); PG8_BAR; PG8_MMA(1, 0, At, B0); PG8_MMA(1, 1, At, B1); PG8_BAR; PG8_SCHED;
            } else {
            PG8_LDB(B0, 0, 0); PG8_SCHED; PG8_LDA(At, 0, 0); PG8_STAGE(PG8_SA(1, 1), a1 + hstep, voffA);
            PG8_WAIT_L(8); PG8_BAR; PG8_WAIT_L(0); PG8_MMA(0, 0, At, B0); PG8_BAR; PG8_SCHED;
            PG8_LDB(B1, 0, 1); PG8_STAGE(PG8_SB(0, 0), b2, voffB);
            PG8_BAR; PG8_WAIT_L(0); PG8_MMA(0, 1, At, B1); PG8_BAR;
            PG8_LDA(At, 0, 1); PG8_STAGE(PG8_SA(0, 0), a2, voffA);
            PG8_BAR; PG8_WAIT_L(0); PG8_MMA(1, 0, At, B0); PG8_BAR; PG8_SCHED;
            PG8_STAGE(PG8_SB(0, 1), b2 + hstep, voffB);
            PG8_WAIT_V(6); PG8_BAR; PG8_MMA(1, 1, At, B1); PG8_BAR;
            PG8_LDB(B0, 1, 0); PG8_SCHED; PG8_LDA(At, 1, 0); PG8_STAGE(PG8_SA(0, 1), a2 + hstep, voffA);
            PG8_WAIT_L(8); PG8_BAR; PG8_WAIT_L(0); PG8_MMA(0, 0, At, B0); PG8_BAR; PG8_SCHED;
            PG8_LDB(B1, 1, 1); PG8_STAGE(PG8_SB(1, 0), b3, voffB);
            PG8_BAR; PG8_WAIT_L(0); PG8_MMA(0, 1, At, B1); PG8_BAR;
            PG8_LDA(At, 1, 1); PG8_STAGE(PG8_SA(1, 0), a3, voffA);
            PG8_BAR; PG8_WAIT_L(0); PG8_MMA(1, 0, At, B0); PG8_BAR; PG8_SCHED;
            PG8_STAGE(PG8_SB(1, 1), b3 + hstep, voffB);
            PG8_WAIT_V(6); PG8_BAR; PG8_MMA(1, 1, At, B1); PG8_BAR;
            }
        }
        if (wr == 0) PG8_BAR;
        E(acc, cur, wr, wc, fr, fq);
        if (!has_next) break;
#pragma unroll
        for (int a = 0; a < 2; ++a)
#pragma unroll
            for (int b = 0; b < 2; ++b)
#pragma unroll
                for (int m = 0; m < 4; ++m)
#pragma unroll
                    for (int n = 0; n < 2; ++n) acc[a][b][m][n] = (f32x4){0.f, 0.f, 0.f, 0.f};
        cur = nxt; cA = nA; cB = nB; ++ui;
        if (wr == 1) PG8_BAR;
    }
    PG8_WAIT_V(0);
    PG8_BAR;
#undef PG8_SA
#undef PG8_SB
#undef PG8_STAGE
#undef PG8_LDA
#undef PG8_LDB
#undef PG8_MMA
#undef PG8_WAIT_V
#undef PG8_WAIT_L
#undef PG8_BAR
#undef PG8_SCHED
}
}

struct Args { const float* in[29]; float* out; unsigned char* ws; float inv32[16]; float inv16[8]; int ph_lo, ph_hi; };

struct Frame {
    LAS unsigned char* lds;
    int tid, lane, wave, G, bid;
    unsigned char* ws;
};

#define LDS_WAIT() asm volatile("s_waitcnt lgkmcnt(0)" ::: "memory")

template <int MODE>
__device__ __forceinline__ void transpose_item(const float* W, const float* W2, int K, int Nsrc, int Ndst, bf16_t* WT, LAS float* scr, int item, int lane) {
    const int nblk = Ndst / 64, kb = item / nblk, nb = item % nblk, k0 = 64 * kb, n0 = 64 * nb;
    const int c4 = lane & 15, r4 = lane >> 4;
    const float* src; bool ok = true; int lcol;
    if (MODE == 0) { src = W + n0 + 4 * c4; ok = (n0 + 4 * c4) < Nsrc; lcol = 4 * c4; }
    else if (MODE == 2) {
        const int n = n0 + 4 * c4; int sc = -1; if (n < 3264) sc = 2120 + n; else if (n >= 3328 && n < 3328 + 2120) sc = n - 3328;
        ok = sc >= 0; src = W + (ok ? sc : 0); lcol = 4 * c4; }
    else if (MODE == 3) { const int n = n0 + 4 * c4; ok = n < 2120; src = W + (ok ? n : 0); lcol = 4 * c4; }
    else { const int t = c4 >> 3, g = c4 & 7; src = (t ? W2 : W) + n0 / 2 + 4 * g; lcol = 8 * g + 4 * t; }
    f32x4 v[16];
#pragma unroll
    for (int i = 0; i < 16; ++i) v[i] = ok ? *(const f32x4*)(src + (size_t)(k0 + 4 * i + r4) * Nsrc) : (f32x4){0.f, 0.f, 0.f, 0.f};
#pragma unroll
    for (int i = 0; i < 16; ++i) { LAS float* d = scr + (4 * i + r4) * 65 + lcol; d[0] = v[i].x; d[1] = v[i].y; d[2] = v[i].z; d[3] = v[i].w; }
    LDS_WAIT(); asm volatile("" ::: "memory");
    const int c = lane & 7;
#pragma unroll
    for (int j = 0; j < 8; ++j) { const int n = (lane >> 3) + 8 * j; const LAS float* sp = scr + (8 * c) * 65 + n;
        u32x4 o; o.x = pk2(sp[0 * 65], sp[1 * 65]); o.y = pk2(sp[2 * 65], sp[3 * 65]); o.z = pk2(sp[4 * 65], sp[5 * 65]); o.w = pk2(sp[6 * 65], sp[7 * 65]);
        *(u32x4*)(WT + (size_t)(n0 + n) * K + k0 + 8 * c) = o; }
    LDS_WAIT(); asm volatile("" ::: "memory");
}
template <int MODE>
__device__ __forceinline__ void convert_weight(Frame& F, const float* W, const float* W2, int K, int Nsrc, int Ndst, bf16_t* WT) {
    LAS float* scr = (LAS float*)(F.lds + F.wave * 17408);
    const int gw = F.bid * NWAVES + F.wave, NGW = F.G * NWAVES, nitems = (K / 64) * (Ndst / 64);
    for (int it = gw; it < nitems; it += NGW) transpose_item<MODE>(W, W2, K, Nsrc, Ndst, WT, scr, it, F.lane);
}
template <bool OUT_BF16>
__device__ __forceinline__ void rmsnorm_rows(Frame& F, const float* X, const float* gain, void* O) {
    const int gw = F.bid * NWAVES + F.wave, NGW = F.G * NWAVES;
    f32x4 gv[8];
#pragma unroll
    for (int j = 0; j < 8; ++j) gv[j] = ((const f32x4*)gain)[F.lane + 64 * j];
    for (int m = gw; m < S; m += NGW) {
        const f32x4* xr = (const f32x4*)(X + (size_t)m * DM) + F.lane;
        f32x4 v[8]; float s = 0.f;
#pragma unroll
        for (int j = 0; j < 8; ++j) { v[j] = xr[64 * j]; s += (v[j].x * v[j].x + v[j].y * v[j].y) + (v[j].z * v[j].z + v[j].w * v[j].w); }
        const float rs = 1.f / sqrtf(wave_sum(s) * (1.f / DM) + NORM_EPS);
        if (OUT_BF16) {
            u32x2* o8 = (u32x2*)((bf16_t*)O + (size_t)m * DM) + F.lane;
#pragma unroll
            for (int j = 0; j < 8; ++j) { u32x2 w; w.x = pk2(v[j].x * rs * gv[j].x, v[j].y * rs * gv[j].y); w.y = pk2(v[j].z * rs * gv[j].z, v[j].w * rs * gv[j].w); o8[64 * j] = w; }
        } else {
            f32x4* o = (f32x4*)((float*)O + (size_t)m * DM) + F.lane;
#pragma unroll
            for (int j = 0; j < 8; ++j) o[64 * j] = v[j] * rs * gv[j];
        }
    }
}

#define XB_TMO      128
#define XB_XCNT(j)  (256  + 64 * (j))
#define XB_XSUB(j)  (1280 + 64 * (j))
#define XB_XGEN(j)  (2304 + 64 * (j))
#define XB_TOP      3328
#define XB_TOPGEN   3392
#define XCD_BAR_WORDS 3456
#define XB_SPIN_CAP (1u << 18)

__device__ __forceinline__ unsigned xb_ld(unsigned* p)              { return __hip_atomic_load(p, __ATOMIC_RELAXED, __HIP_MEMORY_SCOPE_AGENT); }
__device__ __forceinline__ unsigned xb_add(unsigned* p, unsigned v) { return __hip_atomic_fetch_add(p, v, __ATOMIC_RELAXED, __HIP_MEMORY_SCOPE_AGENT); }
__device__ __forceinline__ unsigned xb_xcc_id() { return (unsigned)__builtin_amdgcn_s_getreg((3 << 11) | 20) & 0xFu; }
#define XB_SPIN(cond, bar) do { unsigned _sp = 0; while (cond) { __builtin_amdgcn_s_sleep(1); \
    if ((++_sp & 255u) == 0u) { if (xb_ld(&(bar)[XB_TMO])) break; if (_sp > XB_SPIN_CAP) { atomicAdd(&(bar)[XB_TMO], 1u); break; } } } } while (0)

struct XcdBarrier {
    unsigned* bar; unsigned x; unsigned G;
    volatile LAS unsigned* st;
};

__device__ __forceinline__ XcdBarrier xcd_barrier_post(unsigned* bar, volatile LAS unsigned* st, unsigned G, bool participate) {
    XcdBarrier b; b.bar = bar; b.x = xb_xcc_id(); b.st = st; b.G = G;
    if (participate && threadIdx.x == 0) (void)xb_add(&bar[XB_XCNT(b.x)], 1u);
    return b;
}
__device__ __forceinline__ void xcd_barrier_complete(unsigned* bar, unsigned x, unsigned& nloc, unsigned& nx, const unsigned G) {
    unsigned sum, cnt, mine, sp = 0u;
    for (;;) {
        sum = 0u; cnt = 0u; mine = 0u;
#pragma unroll
        for (unsigned j = 0; j < 16; ++j) { const unsigned c = xb_ld(&bar[XB_XCNT(j)]); sum += c; cnt += (c > 0u) ? 1u : 0u; mine = (j == x) ? c : mine; }
        if (sum == G) break;
        __builtin_amdgcn_s_sleep(1);
        if ((++sp & 255u) == 0u) { if (xb_ld(&bar[XB_TMO])) break; if (sp > XB_SPIN_CAP) { atomicAdd(&bar[XB_TMO], 1u); break; } }
    }
    nloc = mine > 0u ? mine : 1u; nx = cnt > 0u ? cnt : 1u;
}

__device__ __forceinline__ void xcd_barrier(const XcdBarrier& b) {
    asm volatile("s_waitcnt vmcnt(0)" ::: "memory");
    __syncthreads();
    if (threadIdx.x == 0) {
        unsigned* bar = b.bar;
        __builtin_amdgcn_s_waitcnt(0);
        unsigned nloc = b.st[0], nx = b.st[1];
        if (nloc == 0u) { xcd_barrier_complete(bar, b.x, nloc, nx, b.G); b.st[0] = nloc; b.st[1] = nx; }
        const unsigned old = xb_add(&bar[XB_XSUB(b.x)], 1u);
        const unsigned gen = old / nloc;
        if (old + 1u == (gen + 1u) * nloc) {
            __builtin_amdgcn_fence(__ATOMIC_RELEASE, "agent");
            asm volatile("s_waitcnt vmcnt(0)" ::: "memory");
            const unsigned og = xb_add(&bar[XB_TOP], 1u);
            const unsigned tg = og / nx;
            if (og + 1u == (tg + 1u) * nx) xb_add(&bar[XB_TOPGEN], 1u);
            else XB_SPIN(xb_ld(&bar[XB_TOPGEN]) == tg, bar);
            __builtin_amdgcn_fence(__ATOMIC_ACQUIRE, "agent");
            xb_add(&bar[XB_XGEN(b.x)], 1u);
            asm volatile("s_waitcnt vmcnt(0)" ::: "memory");
        } else {
            XB_SPIN(xb_ld(&bar[XB_XGEN(b.x)]) == gen, bar);
            __builtin_amdgcn_fence(__ATOMIC_ACQUIRE, "agent");
            asm volatile("s_waitcnt vmcnt(0)" ::: "memory");
        }
    }
    __syncthreads();
}

__device__ __forceinline__ void xcd_wait(unsigned* bar, unsigned k) {
    __syncthreads();
    if (threadIdx.x == 0) {
        XB_SPIN(xb_ld(&bar[XB_TOPGEN]) < k, bar);
        __builtin_amdgcn_fence(__ATOMIC_ACQUIRE, "agent");
        asm volatile("s_waitcnt vmcnt(0)" ::: "memory");
    }
    __syncthreads();
}
__device__ __forceinline__ void shadow_barrier(unsigned* ctr, unsigned target, bool arrive) {
    __syncthreads();
    if (threadIdx.x == 0) {
        __threadfence();
        if (arrive) __hip_atomic_fetch_add(ctr, 1u, __ATOMIC_RELAXED, __HIP_MEMORY_SCOPE_AGENT);
        while (__hip_atomic_load(ctr, __ATOMIC_RELAXED, __HIP_MEMORY_SCOPE_AGENT) < target) __builtin_amdgcn_s_sleep(2);
        __threadfence();
    }
    __syncthreads();
}
__device__ __forceinline__ float sigmoidf_(float x) { return 1.f / (1.f + __expf(-x)); }
__device__ __forceinline__ void rope_pair(bf16_t* p, int half, int i, float ang_rev) {
    const float sn = __builtin_amdgcn_sinf(ang_rev), cs = __builtin_amdgcn_cosf(ang_rev);
    const float x1 = bf2f(p[i]), x2 = bf2f(p[i + half]);
    p[i] = (bf16_t)f2bf(x1 * cs - x2 * sn); p[i + half] = (bf16_t)f2bf(x2 * cs + x1 * sn);
}
__device__ __forceinline__ float half_sum(float v, bool upper) {
    v += dppf<0xB1>(v); v += dppf<0x4E>(v); v += dppf<0x141>(v); v += dppf<0x140>(v);
    v += dppf_m<0x142, 0xA>(0.f, v);
    const float s31 = __builtin_bit_cast(float, __builtin_amdgcn_readlane(__builtin_bit_cast(int, v), 31));
    const float s63 = __builtin_bit_cast(float, __builtin_amdgcn_readlane(__builtin_bit_cast(int, v), 63));
    return upper ? s63 : s31;
}
__device__ __forceinline__ void prep_rwkv(Frame& F, const Args& a, int tile_lo, int tile_hi, int idx, int nwg) {
    bf16_t* U = (bf16_t*)(F.ws + WS_U);
    const float *mu_r = a.in[8], *mu_k = a.in[9], *mu_v = a.in[10], *mu_w = a.in[11], *mu_a = a.in[12];
    const float *w0 = a.in[14], *w2 = a.in[15], *a0 = a.in[16], *a2 = a.in[17], *k_k = a.in[19], *k_a = a.in[20], *r_k = a.in[21];
    float* Wd = (float*)(F.ws + WS_W); bf16_t* Ab = (bf16_t*)(F.ws + WS_A); bf16_t* Bb = (bf16_t*)(F.ws + WS_B); bf16_t* Kp = (bf16_t*)(F.ws + WS_KP);
    bf16_t* Rb = (bf16_t*)(F.ws + WS_R); bf16_t* Vb = (bf16_t*)(F.ws + WS_V);
    float* BR = (float*)(F.ws + WS_BR); float* KR = (float*)(F.ws + WS_KR); float* BON = (float*)(F.ws + WS_BON);
    LAS float* xw = (LAS float*)F.lds;
    LAS float* xa = xw + 16 * 64;
    constexpr int TT = 16;
    const int c0 = 2 * F.tid;
    const bool upper = (F.lane & 32) != 0; const int hd = 2 * F.wave + (upper ? 1 : 0);
    const f32x2 mr = *(const f32x2*)(mu_r + c0), mk = *(const f32x2*)(mu_k + c0), mv = *(const f32x2*)(mu_v + c0);
    const f32x2 w0v = *(const f32x2*)(w0 + c0), a0v = *(const f32x2*)(a0 + c0), kkv = *(const f32x2*)(k_k + c0), kav = *(const f32x2*)(k_a + c0), rkv = *(const f32x2*)(r_k + c0);
    for (int tile = tile_lo + idx; tile < tile_hi; tile += nwg) {
        const int t0 = tile * TT;
        __syncthreads();
        for (int e = F.tid; e < TT * 128; e += NTHR) {
            const int tt = e >> 7, d = e & 127, t = t0 + tt; const int col = (d < 64) ? (UWD + d) : (UAD + d - 64);
            const float cur = bf2f(U[(size_t)t * PWP + col]); const float prv = t > 0 ? bf2f(U[(size_t)(t - 1) * PWP + col]) : 0.f;
            const float mu = (d < 64) ? mu_w[d] : mu_a[d - 64];
            const float x = cur + (prv - cur) * mu;
            if (d < 64) xw[tt * 64 + d] = tanhf(x); else xa[tt * 64 + d - 64] = x;
        }
        __syncthreads();
        f32x2 lw[TT], la[TT];
#pragma unroll
        for (int tt = 0; tt < TT; ++tt) { lw[tt] = (f32x2){0.f, 0.f}; la[tt] = (f32x2){0.f, 0.f}; }
        for (int d = 0; d < 64; d += 4) {
            f32x2 ww[4], aa[4];
#pragma unroll
            for (int q = 0; q < 4; ++q) { ww[q] = *(const f32x2*)(w2 + (d + q) * 1024 + c0); aa[q] = *(const f32x2*)(a2 + (d + q) * 1024 + c0); }
#pragma unroll
            for (int tt = 0; tt < TT; ++tt) {
                const f32x4 xv = *(const LAS f32x4*)(xw + tt * 64 + d), av = *(const LAS f32x4*)(xa + tt * 64 + d);
#pragma unroll
                for (int q = 0; q < 4; ++q) { lw[tt] += ww[q] * xv[q]; la[tt] += aa[q] * av[q]; }
            }
        }
        LAS float* lwl = xa + 16 * 64;
        LAS float* lal = lwl + 16 * 1024;
#pragma unroll
        for (int tt = 0; tt < TT; ++tt) { *(LAS f32x2*)(lwl + tt * 1024 + c0) = lw[tt]; *(LAS f32x2*)(lal + tt * 1024 + c0) = la[tt]; }
        unsigned prr = 0u, prk = 0u, prv = 0u;
        if (t0 > 0) { const bf16_t* up = U + (size_t)(t0 - 1) * PWP; prr = *(const unsigned*)(up + URR + c0); prk = *(const unsigned*)(up + URK + c0); prv = *(const unsigned*)(up + URV + c0); }
#pragma unroll 2
        for (int tt = 0; tt < TT; ++tt) {
            const int t = t0 + tt; const bf16_t* ur = U + (size_t)t * PWP;
            const unsigned crr = *(const unsigned*)(ur + URR + c0), crk = *(const unsigned*)(ur + URK + c0), crv = *(const unsigned*)(ur + URV + c0);
            const f32x2 rc = {bflo(crr), bfhi(crr)}, kc = {bflo(crk), bfhi(crk)}, vc = {bflo(crv), bfhi(crv)};
            const f32x2 rp = {bflo(prr), bfhi(prr)}, kp = {bflo(prk), bfhi(prk)}, vp = {bflo(prv), bfhi(prv)};
            prr = crr; prk = crk; prv = crv;
            const f32x2 r = rc + (rp - rc) * mr, k = kc + (kp - kc) * mk, v = vc + (vp - vc) * mv;
            const f32x2 zw = w0v + *(const LAS f32x2*)(lwl + tt * 1024 + c0);
            const f32x2 za = a0v + *(const LAS f32x2*)(lal + tt * 1024 + c0);
            f32x2 decay, alpha;
#pragma unroll
            for (int e = 0; e < 2; ++e) {
                const float nz = -zw[e]; const float sp = fmaxf(nz, 0.f) + log1pf(__expf(-fabsf(nz)));
                decay[e] = __expf(-__expf(-sp - 0.5f)); alpha[e] = sigmoidf_(za[e]); }
            f32x2 kk = k * kkv;
            const float nrm = sqrtf(half_sum(kk.x * kk.x + kk.y * kk.y, upper));
            const float inv = 1.f / fmaxf(nrm, 1e-12f); kk = kk * inv;
            const f32x2 kmod = k * (1.f + (alpha - 1.f) * kav);
            const f32x2 bb = kk * alpha;
            const float br = half_sum(bb.x * r.x + bb.y * r.y, upper), kr = half_sum(kmod.x * r.x + kmod.y * r.y, upper);
            const float bon = half_sum(r.x * kmod.x * rkv.x + r.y * kmod.y * rkv.y, upper);
            const size_t o = (size_t)t * 1024 + c0;
            *(f32x2*)(Wd + o) = decay;
            *(unsigned*)(Ab + o) = pk2(-kk.x, -kk.y); *(unsigned*)(Bb + o) = pk2(bb.x, bb.y); *(unsigned*)(Kp + o) = pk2(kmod.x, kmod.y);
            *(unsigned*)(Rb + o) = pk2(r.x, r.y); *(unsigned*)(Vb + o) = pk2(v.x, v.y);
            if ((F.lane & 31) == 0) { BR[t * 16 + hd] = br; KR[t * 16 + hd] = kr; BON[t * 16 + hd] = bon; }
        }
    }
}
__device__ __forceinline__ void prep_rope(Frame& F, const Args& a, int idx, int nwg) {
    bf16_t* U = (bf16_t*)(F.ws + WS_U);
    constexpr int TT = 16;
    for (int tile = idx; tile < S / TT; tile += nwg) {
        const int t0 = tile * TT;
        for (int e = F.tid; e < TT * 232; e += NTHR) {
            const int tt = e / 232, p = e % 232, t = t0 + tt;
            bf16_t* ur = U + (size_t)t * PWP;
            int base, half, i; float invf;
            if (p < 160) { const int hd = p >> 4; i = p & 15; half = 16; base = (hd < 8) ? (UQ + 128 * hd) : (UK + 128 * (hd - 8)); invf = a.inv32[i]; }
            else { const int q = p - 160, hd = q >> 3; i = q & 7; half = 8; base = (hd < 8) ? (UQI + 64 * hd) : UKI; invf = a.inv16[i]; }
            const float ang = (float)t * invf;
            const double rev = (double)ang * 0.15915494309189535;
            const float fr = (float)(rev - rint(rev));
            rope_pair(ur + base, half, i, fr);
            if (p >= 224) { bf16_t* k2 = (bf16_t*)(F.ws + WS_KI2) + (size_t)t * 64; k2[i] = ur[UKI + i]; k2[i + 8] = ur[UKI + i + 8]; }
            if (p >= 128 && p < 160) { const int gg = (p >> 4) - 8; bf16_t* k2 = (bf16_t*)(F.ws + WS_KV2) + ((size_t)t * 2 + gg) * 256; k2[i] = ur[UK + 128 * gg + i]; k2[i + 16] = ur[UK + 128 * gg + i + 16]; }
        }
        for (int e = F.tid; e < TT * 224; e += NTHR) {
            const int tt = e / 224, r = e % 224, gg = r / 112, c2 = r % 112, t = t0 + tt;
            unsigned* dst = (unsigned*)((bf16_t*)(F.ws + WS_KV2) + ((size_t)t * 2 + gg) * 256);
            if (c2 < 48) dst[16 + c2] = ((const unsigned*)(U + (size_t)t * PWP + UK + 128 * gg + 32))[c2];
            else dst[64 + (c2 - 48)] = ((const unsigned*)(U + (size_t)t * PWP + UV + 128 * gg))[c2 - 48];
        }
        for (int e = F.tid; e < TT * 24; e += NTHR) {
            const int tt = e / 24, c2 = e % 24, t = t0 + tt;
            ((unsigned*)((bf16_t*)(F.ws + WS_KI2) + (size_t)t * 64 + 16))[c2] = ((const unsigned*)(U + (size_t)t * PWP + UKI + 16))[c2];
        }
    }
}

constexpr int RW_TB = 32, RW_REC = 384;
struct RwOps { f32x4 w, a, b, k, wr, vs; };
__device__ __forceinline__ void rwkv_scan(Frame& F, int wg, unsigned* shw, unsigned wait_target, int wait_blk) {
    const int h = wg >> 2, rq = wg & 3;
    const float* Wd = (const float*)(F.ws + WS_W); const bf16_t* Ab = (const bf16_t*)(F.ws + WS_A); const bf16_t* Bb = (const bf16_t*)(F.ws + WS_B); const bf16_t* Kp = (const bf16_t*)(F.ws + WS_KP);
    const bf16_t* Rb = (const bf16_t*)(F.ws + WS_R); const bf16_t* Vb = (const bf16_t*)(F.ws + WS_V);
    const float* BR = (const float*)(F.ws + WS_BR); const float* KR = (const float*)(F.ws + WS_KR);
    LAS float* buf = (LAS float*)F.lds;
    const bool loader = F.wave >= 4;
    const int lt = F.tid - 256, lstep = lt >> 3, part = lt & 7;
    struct LdRegs { f32x4 w0, w1; u32x4 a, b, k, r, v; float br, kr; };
    auto gload = [&](LdRegs& L, int blk) {
        const int t = blk * RW_TB + lstep; const size_t o = (size_t)t * 1024 + h * 64 + 8 * part;
        L.w0 = *(const f32x4*)(Wd + o); L.w1 = *(const f32x4*)(Wd + o + 4);
        L.a = *(const u32x4*)(Ab + o); L.b = *(const u32x4*)(Bb + o); L.k = *(const u32x4*)(Kp + o); L.r = *(const u32x4*)(Rb + o);
        if (part < 2) { L.v = *(const u32x4*)(Vb + (size_t)t * 1024 + h * 64 + 16 * rq + 8 * part); L.br = BR[t * 16 + h]; L.kr = KR[t * 16 + h]; }
    };
    auto lstore = [&](const LdRegs& L, int b) {
        LAS float* rec = buf + (b * RW_TB + lstep) * RW_REC;
        const u32x4 av = L.a, bv = L.b, kv = L.k, rv = L.r;
        f32x4 a_0 = {bflo(av.x), bfhi(av.x), bflo(av.y), bfhi(av.y)}, a_1 = {bflo(av.z), bfhi(av.z), bflo(av.w), bfhi(av.w)};
        f32x4 b_0 = {bflo(bv.x), bfhi(bv.x), bflo(bv.y), bfhi(bv.y)}, b_1 = {bflo(bv.z), bfhi(bv.z), bflo(bv.w), bfhi(bv.w)};
        f32x4 k_0 = {bflo(kv.x), bfhi(kv.x), bflo(kv.y), bfhi(kv.y)}, k_1 = {bflo(kv.z), bfhi(kv.z), bflo(kv.w), bfhi(kv.w)};
        f32x4 r_0 = {bflo(rv.x), bfhi(rv.x), bflo(rv.y), bfhi(rv.y)}, r_1 = {bflo(rv.z), bfhi(rv.z), bflo(rv.w), bfhi(rv.w)};
        *(LAS f32x4*)(rec + 8 * part) = L.w0; *(LAS f32x4*)(rec + 8 * part + 4) = L.w1;
        *(LAS f32x4*)(rec + 64 + 8 * part) = a_0; *(LAS f32x4*)(rec + 64 + 8 * part + 4) = a_1;
        *(LAS f32x4*)(rec + 128 + 8 * part) = b_0; *(LAS f32x4*)(rec + 128 + 8 * part + 4) = b_1;
        *(LAS f32x4*)(rec + 192 + 8 * part) = k_0; *(LAS f32x4*)(rec + 192 + 8 * part + 4) = k_1;
        *(LAS f32x4*)(rec + 256 + 8 * part) = L.w0 * r_0; *(LAS f32x4*)(rec + 256 + 8 * part + 4) = L.w1 * r_1;
        if (part < 2) { const u32x4 vv = L.v;
            const float v8[8] = {bflo(vv.x), bfhi(vv.x), bflo(vv.y), bfhi(vv.y), bflo(vv.z), bfhi(vv.z), bflo(vv.w), bfhi(vv.w)};
#pragma unroll
            for (int e = 0; e < 8; ++e) *(LAS f32x4*)(rec + 320 + (8 * part + e) * 4) = (f32x4){v8[e], v8[e] * L.kr, L.br, 0.f}; }
    };
    LdRegs L0, L1;
    __syncthreads();
    if (loader) { gload(L0, 0); lstore(L0, 0); gload(L0, 1); gload(L1, 2); }
    __syncthreads();
    const int rg = F.lane >> 4, j = F.lane & 15, row = 16 * rq + 4 * F.wave + rg;
    f32x4 st = {0.f, 0.f, 0.f, 0.f};
    unsigned char* Ub = F.ws + WS_U;
    const bool odd1 = (j & 1) != 0, odd2 = (j & 2) != 0;
    constexpr int NBLK = S / RW_TB;
    auto scan_block = [&](int blk) {
            const LAS float* rb = buf + ((blk & 1) * RW_TB) * RW_REC + 4 * j;
            const LAS float* rv_ = buf + ((blk & 1) * RW_TB) * RW_REC + 320 + (4 * F.wave + rg) * 4;
#define RW_LD(R, st_) do { const int off_ = (st_) * RW_REC; R.w = *(const LAS f32x4*)(rb + off_); R.a = *(const LAS f32x4*)(rb + off_ + 64); R.b = *(const LAS f32x4*)(rb + off_ + 128); \
                R.k = *(const LAS f32x4*)(rb + off_ + 192); R.wr = *(const LAS f32x4*)(rb + off_ + 256); R.vs = *(const LAS f32x4*)(rv_ + off_); } while (0)
            RwOps R[4];
            RW_LD(R[0], 0); RW_LD(R[1], 1); RW_LD(R[2], 2);
            for (int s4 = 0; s4 < RW_TB; s4 += 4) {
                float pz[4], u[4];
#pragma unroll
                for (int q = 0; q < 4; ++q) {
                    RW_LD(R[(q + 3) & 3], s4 + q + 3);
                    const RwOps& cur = R[q];
                    const f32x2 slo = {st.x, st.y}, shi = {st.z, st.w};
                    f32x2 ma = slo * (f32x2){cur.a.x, cur.a.y}; ma = __builtin_elementwise_fma(shi, (f32x2){cur.a.z, cur.a.w}, ma);
                    f32x2 mz = slo * (f32x2){cur.wr.x, cur.wr.y}; mz = __builtin_elementwise_fma(shi, (f32x2){cur.wr.z, cur.wr.w}, mz);
                    float psa = ma.x + ma.y; pz[q] = mz.x + mz.y;
                    const f32x2 vb = {cur.vs.x, cur.vs.x};
                    f32x2 tlo = (f32x2){cur.k.x, cur.k.y} * vb, thi = (f32x2){cur.k.z, cur.k.w} * vb;
                    tlo = __builtin_elementwise_fma(slo, (f32x2){cur.w.x, cur.w.y}, tlo); thi = __builtin_elementwise_fma(shi, (f32x2){cur.w.z, cur.w.w}, thi);
                    psa = red16(psa);
                    const f32x2 pb = {psa, psa};
                    tlo = __builtin_elementwise_fma((f32x2){cur.b.x, cur.b.y}, pb, tlo); thi = __builtin_elementwise_fma((f32x2){cur.b.z, cur.b.w}, pb, thi);
                    st = (f32x4){tlo.x, tlo.y, thi.x, thi.y};
                    u[q] = psa * cur.vs.z + cur.vs.y;
                }
                const float qa = (odd1 ? pz[1] : pz[0]) + dppf<0xB1>(odd1 ? pz[0] : pz[1]);
                const float qb = (odd1 ? pz[3] : pz[2]) + dppf<0xB1>(odd1 ? pz[2] : pz[3]);
                float r = (odd2 ? qb : qa) + dppf<0x4E>(odd2 ? qa : qb);
                r += dppf<0x124>(r); r += dppf<0x128>(r);
                const float us = odd2 ? (odd1 ? u[3] : u[2]) : (odd1 ? u[1] : u[0]);
                if (j < 4) { const int t = blk * RW_TB + s4 + j; ((float*)(Ub + (size_t)t * (PWP * 2) + URR * 2))[h * 64 + row] = r + us; }
            }
    };
    for (int blk = 0; blk < NBLK; blk += 2) {
        if (blk == wait_blk) xcd_wait(shw, wait_target);
        if (loader) { lstore(L0, 1); if (blk + 3 < NBLK) gload(L0, blk + 3); }
        else scan_block(blk);
        __syncthreads();
        if (loader) { if (blk + 2 < NBLK) { lstore(L1, 0); if (blk + 4 < NBLK) gload(L1, blk + 4); } }
        else scan_block(blk + 1);
        __syncthreads();
    }
}

constexpr int DSA_CAP = 640;
constexpr int DW_SC = 0, DW_IX = 4 * DSA_CAP * 4  , DW_P = DW_IX + 4 * DSA_CAP * 2  , DW_BYTES = DW_P + 4096  ;
static_assert(8 * DW_BYTES <= LDS_BYTES, "dsa lds");
typedef short v4i16_t __attribute__((ext_vector_type(4)));
__device__ __forceinline__ unsigned ukey(float f) { const unsigned b = __builtin_bit_cast(unsigned, f); return (b & 0x80000000u) ? ~b : (b | 0x80000000u); }
__device__ __forceinline__ float ukey_inv(unsigned k) { const unsigned b = (k & 0x80000000u) ? (k & 0x7fffffffu) : ~k; return __builtin_bit_cast(float, b); }
__device__ __forceinline__ int popc64(unsigned long long m) { return __builtin_popcountll(m); }
__device__ __forceinline__ int lanes_below(unsigned long long m) { return __builtin_amdgcn_mbcnt_hi((unsigned)(m >> 32), __builtin_amdgcn_mbcnt_lo((unsigned)m, 0u)); }

__device__ __forceinline__ float dsa_compact(const bool EXACT, LAS float* scl, LAS unsigned short* ixl, int n, int lane, int& ncnt) {
    float e[10]; unsigned x[10], uk[10];
#pragma unroll
    for (int i = 0; i < 10; ++i) { const int p = lane + 64 * i; const bool v = p < n; e[i] = v ? scl[p] : -INFINITY; x[i] = v ? ixl[p] : 0u; uk[i] = v ? ukey(e[i]) : 0u; }
    unsigned prefix = 0u;
    const int lowbit = EXACT ? 0 : 14;
    for (int bit = 31; bit >= lowbit; --bit) {
        const unsigned trial = prefix | (1u << bit); int c = 0;
#pragma unroll
        for (int i = 0; i < 10; ++i) c += popc64(__ballot(uk[i] >= trial));
        if (c >= 256) prefix = trial;
    }
    int need = 1 << 30;
    if (EXACT) { int cgt = 0;
#pragma unroll
        for (int i = 0; i < 10; ++i) cgt += popc64(__ballot(uk[i] > prefix));
        need = 256 - cgt; }
    int base = 0, tseen = 0;
#pragma unroll
    for (int i = 0; i < 10; ++i) {
        const bool gt = uk[i] > prefix, eq = uk[i] == prefix;
        const unsigned long long meq = __ballot(eq); const bool keep = gt || (eq && (tseen + lanes_below(meq)) < need); tseen += popc64(meq);
        const unsigned long long mk = __ballot(keep);
        if (keep) { const int pos = base + lanes_below(mk); scl[pos] = e[i]; ixl[pos] = (unsigned short)x[i]; }
        base += popc64(mk);
    }
    ncnt = base;
    return ukey_inv(prefix);
}

__device__ __forceinline__ void dsa_phase(Frame& F) {
    const bf16_t* U = (const bf16_t*)(F.ws + WS_U);
    const bf16_t* KI2 = (const bf16_t*)(F.ws + WS_KI2);
    const bf16_t* KV2 = (const bf16_t*)(F.ws + WS_KV2);
    bf16_t* MIX = (bf16_t*)(F.ws + WS_XN);
    unsigned* ctr = (unsigned*)(F.ws + WS_CTL);
    const int lane = F.lane, w = F.wave;
    LAS unsigned char* wl = F.lds + w * DW_BYTES;
    LAS float* scb = (LAS float*)(wl + DW_SC);
    LAS unsigned short* ixb = (LAS unsigned short*)(wl + DW_IX);
    LAS float* Pw = (LAS float*)(wl + DW_P);
    LAS unsigned short* Pb = (LAS unsigned short*)(wl + DW_P);
    LAS unsigned char* vst = wl + DW_SC;
    const int g5 = lane >> 5, n32 = lane & 31;
    for (;;) {
        unsigned item = 0u;
        if (lane == 0) item = atomicAdd(ctr, 1u);
        item = (unsigned)__builtin_amdgcn_readfirstlane((int)item);
        if (item >= 4096u) break;
        const int tq0 = (4095 - (int)item) * 4, ch = tq0 >> 6, nkb = ch + 1;
        bf16x8 afr[4];
        { const int rho = n32, b = rho >> 3, g = (rho >> 2) & 1, r = rho & 3, qq = 2 * g + (b >> 1), hh = 4 * (b & 1) + r;
          const bf16_t* src = U + (size_t)(tq0 + qq) * PWP + UQI + 64 * hh + 8 * g5;
#pragma unroll
          for (int ks = 0; ks < 4; ++ks) afr[ks] = *(const bf16x8*)(src + 16 * ks); }
        float wgt[16];
#pragma unroll
        for (int i = 0; i < 16; ++i) { const int qq = 2 * g5 + (i >> 3), hh = 4 * ((i >> 2) & 1) + (i & 3); wgt[i] = bf2f(U[(size_t)(tq0 + qq) * PWP + UWI + hh]) * 0.044194173824159216f; }
        int cnt0 = 0, cnt1 = 0, cnt2 = 0, cnt3 = 0;
        float tau0 = -INFINITY, tau1 = -INFINITY;
        const bf16_t* kbase = KI2 + (size_t)n32 * 64 + 8 * g5;
#define DSA_LOADB(B, kb_) do { _Pragma("unroll") for (int cb_ = 0; cb_ < 2; ++cb_) _Pragma("unroll") for (int ks_ = 0; ks_ < 4; ++ks_) \
            B[cb_][ks_] = *(const bf16x8*)(kbase + (size_t)(kb_) * 4096 + cb_ * 2048 + ks_ * 16); } while (0)
#define DSA_COMPACT_ALL(FIN, SCHED) do { _Pragma("unroll 1") for (int ql_ = 0; ql_ < 4; ++ql_) { \
            int c_ = (ql_ == 0) ? cnt0 : (ql_ == 1) ? cnt1 : (ql_ == 2) ? cnt2 : cnt3; \
            int mode_ = (FIN) ? (c_ > 256 ? 2 : 0) : ((c_ > 512) ? 1 : 0); \
            float thr_ = 0.f; bool did_ = false; \
            while (mode_) { int nc_; thr_ = dsa_compact(mode_ == 2, scb + ql_ * DSA_CAP, ixb + ql_ * DSA_CAP, c_, lane, nc_); c_ = nc_; did_ = true; mode_ = (mode_ == 1 && c_ > 512) ? 2 : 0; } \
            if (did_) { if (ql_ == 0) cnt0 = c_; else if (ql_ == 1) cnt1 = c_; else if (ql_ == 2) cnt2 = c_; else cnt3 = c_; \
                if (g5 == (ql_ >> 1)) { if (ql_ & 1) tau1 = thr_; else tau0 = thr_; } } } } while (0)
#define DSA_SCORE(B, kb_) do { \
            f32x16 acc0_, acc1_; \
            _Pragma("unroll") for (int i_ = 0; i_ < 16; ++i_) { acc0_[i_] = 0.f; acc1_[i_] = 0.f; } \
            _Pragma("unroll") for (int ks_ = 0; ks_ < 4; ++ks_) { acc0_ = __builtin_amdgcn_mfma_f32_32x32x16_bf16(afr[ks_], B[0][ks_], acc0_, 0, 0, 0); \
                acc1_ = __builtin_amdgcn_mfma_f32_32x32x16_bf16(afr[ks_], B[1][ks_], acc1_, 0, 0, 0); } \
            _Pragma("unroll") for (int cb_ = 0; cb_ < 2; ++cb_) { \
                float s0 = 0.f, s1 = 0.f; \
                _Pragma("unroll") for (int i_ = 0; i_ < 8; ++i_) { const float r0_ = __builtin_amdgcn_fmed3f(cb_ ? acc1_[i_] : acc0_[i_], 0.f, INFINITY), r1_ = __builtin_amdgcn_fmed3f(cb_ ? acc1_[8 + i_] : acc0_[8 + i_], 0.f, INFINITY); \
                    s0 = __builtin_fmaf(wgt[i_], r0_, s0); s1 = __builtin_fmaf(wgt[8 + i_], r1_, s1); } \
                const unsigned key_ = (unsigned)((kb_) * 64 + cb_ * 32 + n32); \
                const bool p0_ = s0 > tau0, p1_ = s1 > tau1; \
                const unsigned long long m0 = __ballot(p0_), m1 = __ballot(p1_); \
                const unsigned m0h = g5 ? (unsigned)(m0 >> 32) : (unsigned)m0, m1h = g5 ? (unsigned)(m1 >> 32) : (unsigned)m1; \
                const unsigned below = (1u << n32) - 1u; \
                if (p0_) { const int pos = (2 * g5) * DSA_CAP + (g5 ? cnt2 : cnt0) + __builtin_popcount(m0h & below); scb[pos] = s0; ixb[pos] = (unsigned short)key_; } \
                if (p1_) { const int pos = (2 * g5 + 1) * DSA_CAP + (g5 ? cnt3 : cnt1) + __builtin_popcount(m1h & below); scb[pos] = s1; ixb[pos] = (unsigned short)key_; } \
                cnt0 += __builtin_popcount((unsigned)m0); cnt2 += __builtin_popcount((unsigned)(m0 >> 32)); \
                cnt1 += __builtin_popcount((unsigned)m1); cnt3 += __builtin_popcount((unsigned)(m1 >> 32)); } } while (0)
        bf16x8 bA[2][4], bB[2][4];
        DSA_LOADB(bA, 0);
        int kb = 0;
        while (kb < nkb) {
            if (cnt0 > 512 || cnt1 > 512 || cnt2 > 512 || cnt3 > 512) DSA_COMPACT_ALL(false, false);
            const int rem = nkb - kb;
            if (rem == 1) { DSA_SCORE(bA, kb); kb += 1; break; }
            const int mx = max(max(cnt0, cnt1), max(cnt2, cnt3));
            int np = (DSA_CAP - mx) >> 7; np = min(np, rem >> 1);
            for (int i = 0; i < np; ++i, kb += 2) {
                DSA_LOADB(bB, kb + 1);
                DSA_SCORE(bA, kb);
                DSA_LOADB(bA, min(kb + 2, nkb - 1));
                DSA_SCORE(bB, kb + 1);
            }
        }
        DSA_COMPACT_ALL(true, false);
#undef DSA_LOADB
#undef DSA_SCORE
#undef DSA_COMPACT_ALL
        const int col = lane & 15, kq = lane >> 4;
        for (int ql = 0; ql < 4; ++ql) {
            const int t = tq0 + ql; const int nsel = (ql == 0) ? cnt0 : (ql == 1) ? cnt1 : (ql == 2) ? cnt2 : cnt3;
            const LAS unsigned short* ixl = ixb + ql * DSA_CAP;
            const int nch = nsel >> 5;
            u32x4 gr[8];
#define DSA_GATHER(c, g_, off_) do { _Pragma("unroll") for (int i = 0; i < 8; ++i) { const unsigned kidx = ixl[(c) * 32 + kq + 4 * i]; \
                gr[i] = *(const u32x4*)(KV2 + ((size_t)kidx * 2 + (g_)) * 256 + (off_) + 8 * col); } } while (0)
#define DSA_PUT() do { _Pragma("unroll") for (int i = 0; i < 8; ++i) *(LAS u32x4*)(vst + (kq + 4 * i) * 272 + col * 16) = gr[i]; } while (0)
            for (int g = 0; g < 2; ++g) {
                bf16x8 qf[4];
#pragma unroll
                for (int ks = 0; ks < 4; ++ks) { if (col < 4) qf[ks] = *(const bf16x8*)(U + (size_t)t * PWP + UQ + 128 * (4 * g + col) + 32 * ks + 8 * kq); else qf[ks] = (bf16x8){0, 0, 0, 0, 0, 0, 0, 0}; }
                DSA_GATHER(0, g, 0);
                for (int c = 0; c < nch; ++c) {
                    DSA_PUT();
                    if (c + 1 < nch) DSA_GATHER(c + 1, g, 0); else DSA_GATHER(0, g, 128);
#pragma unroll
                    for (int kb2 = 0; kb2 < 2; ++kb2) {
                        f32x4 a4 = {0.f, 0.f, 0.f, 0.f};
#pragma unroll
                        for (int ks = 0; ks < 4; ++ks) { const bf16x8 kf = *(const LAS bf16x8*)(vst + (16 * kb2 + col) * 272 + (32 * ks + 8 * kq) * 2); a4 = __builtin_amdgcn_mfma_f32_16x16x32_bf16(kf, qf[ks], a4, 0, 0, 0); }
                        if (col < 4) {
#pragma unroll
                            for (int i = 0; i < 4; ++i) Pw[(32 * c + 16 * kb2 + 4 * kq + i) * 4 + col] = a4[i] * 0.08838834764831845f;
                        }
                    }
                }
                f32x4 sv[4]; f32x4 mx = {-INFINITY, -INFINITY, -INFINITY, -INFINITY};
#pragma unroll
                for (int jj = 0; jj < 4; ++jj) { if (lane + 64 * jj < nsel) sv[jj] = *(const LAS f32x4*)(Pw + (lane + 64 * jj) * 4); else sv[jj] = (f32x4){-INFINITY, -INFINITY, -INFINITY, -INFINITY};
#pragma unroll
                    for (int hh = 0; hh < 4; ++hh) mx[hh] = fmaxf(mx[hh], sv[jj][hh]); }
                f32x4 sm = {0.f, 0.f, 0.f, 0.f};
#pragma unroll
                for (int hh = 0; hh < 4; ++hh) { mx[hh] = wave_max(mx[hh]);
#pragma unroll
                    for (int jj = 0; jj < 4; ++jj) { sv[jj][hh] = __expf(sv[jj][hh] - mx[hh]); sm[hh] += sv[jj][hh]; }
                    sm[hh] = 1.f / wave_sum(sm[hh]); }
#pragma unroll
                for (int jj = 0; jj < 4; ++jj)
#pragma unroll
                    for (int hh = 0; hh < 4; ++hh) Pb[hh * 256 + lane + 64 * jj] = (unsigned short)f2bf(sv[jj][hh] * sm[hh]);
                f32x4 oacc[8];
#pragma unroll
                for (int db = 0; db < 8; ++db) oacc[db] = (f32x4){0.f, 0.f, 0.f, 0.f};
                const int tq = col >> 2, tp = col & 3;
                for (int c = 0; c < nch; ++c) {
                    DSA_PUT();
                    if (c + 1 < nch) DSA_GATHER(c + 1, g, 128);
                    bf16x8 pf = (bf16x8){0, 0, 0, 0, 0, 0, 0, 0};
                    if (col < 4) pf = *(const LAS bf16x8*)(Pb + col * 256 + 32 * c + 8 * kq);
                    const LAS unsigned char* vrow = vst + (8 * kq + tq) * 272 + 8 * tp;
#pragma unroll
                    for (int db = 0; db < 8; ++db) {
                        const v4i16_t lo = __builtin_amdgcn_ds_read_tr16_b64_v4i16((LAS v4i16_t*)(vrow + 32 * db));
                        const v4i16_t hi = __builtin_amdgcn_ds_read_tr16_b64_v4i16((LAS v4i16_t*)(vrow + 4 * 272 + 32 * db));
                        const bf16x8 vf = {lo[0], lo[1], lo[2], lo[3], hi[0], hi[1], hi[2], hi[3]};
                        oacc[db] = __builtin_amdgcn_mfma_f32_16x16x32_bf16(vf, pf, oacc[db], 0, 0, 0);
                    }
                }
                if (col < 4) {
#pragma unroll
                    for (int db = 0; db < 8; ++db) { u32x2 o; o.x = pk2(oacc[db][0], oacc[db][1]); o.y = pk2(oacc[db][2], oacc[db][3]);
                        *(u32x2*)(MIX + (size_t)t * DM + 128 * (4 * g + col) + 16 * db + 4 * kq) = o; }
                }
            }
#undef DSA_GATHER
#undef DSA_PUT
        }
    }
}

__device__ __forceinline__ void post_phase(Frame& F, const Args& a) {
    const bf16_t* U = (const bf16_t*)(F.ws + WS_U);
    bf16_t* MIX = (bf16_t*)(F.ws + WS_XN);
    const bf16_t* Vb = (const bf16_t*)(F.ws + WS_V); const float* BON = (const float*)(F.ws + WS_BON);
    const float *mu_g = a.in[13], *g2 = a.in[18], *gng = a.in[22], *gnb = a.in[23];
    LAS float* xg = (LAS float*)F.lds;
    constexpr int TT = 16;
    const int c0 = 2 * F.tid;
    const bool upper = (F.lane & 32) != 0; const int hd = 2 * F.wave + (upper ? 1 : 0);
    const f32x2 ggv = *(const f32x2*)(gng + c0), gbv = *(const f32x2*)(gnb + c0);
    for (int tile = F.bid; tile < S / TT; tile += F.G) {
        const int t0 = tile * TT;
        __syncthreads();
        for (int e = F.tid; e < TT * 64; e += NTHR) {
            const int tt = e >> 6, d = e & 63, t = t0 + tt;
            const float cur = bf2f(U[(size_t)t * PWP + UGD + d]); const float prv = t > 0 ? bf2f(U[(size_t)(t - 1) * PWP + UGD + d]) : 0.f;
            xg[tt * 64 + d] = sigmoidf_(cur + (prv - cur) * mu_g[d]);
        }
        __syncthreads();
        f32x2 gg[TT];
#pragma unroll
        for (int tt = 0; tt < TT; ++tt) gg[tt] = (f32x2){0.f, 0.f};
        for (int d = 0; d < 64; d += 4) {
            f32x2 wv[4];
#pragma unroll
            for (int q = 0; q < 4; ++q) wv[q] = *(const f32x2*)(g2 + (d + q) * 1024 + c0);
#pragma unroll
            for (int tt = 0; tt < TT; ++tt) { const f32x4 xv = *(const LAS f32x4*)(xg + tt * 64 + d);
#pragma unroll
                for (int q = 0; q < 4; ++q) gg[tt] += wv[q] * xv[q]; }
        }
        LAS float* gl = xg + 16 * 64;
#pragma unroll
        for (int tt = 0; tt < TT; ++tt) *(LAS f32x2*)(gl + tt * 1024 + c0) = gg[tt];
#pragma unroll 4
        for (int tt = 0; tt < TT; ++tt) {
            const int t = t0 + tt; const float* yrow = (const float*)((const unsigned char*)U + (size_t)t * (PWP * 2) + URR * 2);
            const f32x2 y = *(const f32x2*)(yrow + c0);
            const unsigned vq = *(const unsigned*)(Vb + (size_t)t * 1024 + c0);
            const float mean = half_sum(y.x + y.y, upper) * (1.f / 64.f); const f32x2 dlt = y - mean;
            const float var = half_sum(dlt.x * dlt.x + dlt.y * dlt.y, upper) * (1.f / 64.f);
            f32x2 o = dlt * (1.f / sqrtf(var + GN_EPS)) * ggv + gbv;
            o += (f32x2){bflo(vq), bfhi(vq)} * BON[t * 16 + hd];
            o = o * *(const LAS f32x2*)(gl + tt * 1024 + c0);
            *(unsigned*)(MIX + (size_t)t * DM + 1024 + c0) = pk2(o.x, o.y);
        }
    }
}

__device__ __forceinline__ void light_grid_barrier(unsigned* ctr, unsigned target) {
    __syncthreads();
    if (threadIdx.x == 0) {
        __threadfence();
        __hip_atomic_fetch_add(ctr, 1u, __ATOMIC_RELAXED, __HIP_MEMORY_SCOPE_AGENT);
        while (__hip_atomic_load(ctr, __ATOMIC_RELAXED, __HIP_MEMORY_SCOPE_AGENT) < target) __builtin_amdgcn_s_sleep(2);
        __threadfence();
    }
    __syncthreads();
}
constexpr int NPHASE = 13;
__global__ void __launch_bounds__(NTHR, 2) fwd_kernel(Args a) {
    extern __shared__ __attribute__((aligned(16))) unsigned char lds_raw[];
    Frame F; F.lds = (LAS unsigned char*)lds_raw; F.tid = threadIdx.x; F.lane = F.tid & 63; F.wave = __builtin_amdgcn_readfirstlane(F.tid >> 6); F.G = gridDim.x; F.bid = blockIdx.x; F.ws = a.ws;
    cg::grid_group grid = cg::this_grid();
    volatile LAS unsigned* xst = (volatile LAS unsigned*)(F.lds + LDS_BYTES - 64);
    if (F.tid < 4) xst[F.tid] = 0u;
    __syncthreads();
    const XcdBarrier xbar = xcd_barrier_post((unsigned*)(F.ws + WS_CTL + 4096), xst, (unsigned)F.G, true);
    const XcdBarrier xbar2 = xcd_barrier_post((unsigned*)(F.ws + WS_CTL + 20480), xst + 2, (unsigned)(F.G - 64), F.bid >= 64);
    const int lo = a.ph_lo, hi = a.ph_hi;
#define IN(k) (lo <= (k) && (k) < hi)
    unsigned nbar = 0; unsigned* barw = (unsigned*)(F.ws + WS_CTL + 256);
    if (lo < 0) grid.sync();
#define SEAM(k) do { if (IN(k) && IN((k) + 1)) xcd_barrier(xbar); } while (0)
    bf16_t* ACT = (bf16_t*)(F.ws + WS_U); bf16_t* XN = (bf16_t*)(F.ws + WS_XN);
    bf16_t* WGU = (bf16_t*)(F.ws + WS_WB); bf16_t* WDN = (bf16_t*)(F.ws + WS_WB2); bf16_t* WOUT = (bf16_t*)(F.ws + WS_WOUT);
    if (IN(0)) {
        if (F.bid == 0 && F.tid == 0) *(unsigned*)(F.ws + WS_CTL) = 0u;
        convert_weight<1>(F, a.in[2], a.in[3], DM, FF, 2 * FF, WGU);
        convert_weight<0>(F, a.in[4], nullptr, FF, DM, DM, WDN);
        rmsnorm_rows<true>(F, a.in[0], a.in[1], XN);
    }
    SEAM(0);
    if (IN(1)) { pg8::Gemm g{XN, WGU, S, 2 * FF, DM}; pg8::StaticOrder So; So.init(S, 2 * FF, F.G, F.bid); pg8::EpiSwiglu E{ACT, FF}; pg8::gemm_phase(F.lds, g, So, E); }
#if defined(PROBE_REPG)
    grid.sync();
    if (IN(1)) { pg8::Gemm g{XN, WGU, S, 2 * FF, DM}; pg8::StaticOrder So; So.init(S, 2 * FF, F.G, F.bid); pg8::EpiSwiglu E{ACT, FF}; pg8::gemm_phase(F.lds, g, So, E); }
#endif
    SEAM(1);
    if (IN(2)) { pg8::Gemm g{ACT, WDN, S, DM, FF}; pg8::StaticOrder So; So.init(S, DM, F.G, F.bid); pg8::EpiResF32 E{a.in[0], a.out, DM, 0.5f}; pg8::gemm_phase(F.lds, g, So, E); }
    SEAM(2);
    if (IN(3)) {
        convert_weight<2>(F, a.in[6], nullptr, DM, PW, NG1, (bf16_t*)(F.ws + WS_KV2));
        convert_weight<3>(F, a.in[6], nullptr, DM, PW, NG2, (bf16_t*)(F.ws + WS_WIN2));
        convert_weight<0>(F, a.in[7], nullptr, DM, DM, DM, WOUT);
        rmsnorm_rows<true>(F, a.out, a.in[5], XN);
    }
#if defined(PROBE_REPC)
    grid.sync();
    if (IN(3)) {
        convert_weight<2>(F, a.in[6], nullptr, DM, PW, NG1, (bf16_t*)(F.ws + WS_KV2));
        convert_weight<3>(F, a.in[6], nullptr, DM, PW, NG2, (bf16_t*)(F.ws + WS_WIN2));
        convert_weight<0>(F, a.in[7], nullptr, DM, DM, DM, WOUT);
        rmsnorm_rows<true>(F, a.out, a.in[5], XN);
    }
#endif
    SEAM(3);
    constexpr int M1 = 16 * 256, T1 = M1 / 16;
    constexpr int NG1A = 3072;
    if (IN(4)) {
        const bf16_t* WIN1 = (const bf16_t*)(F.ws + WS_KV2);
        if (F.bid < 192) { pg8::Gemm g{XN, WIN1, M1, NG1A, DM}; pg8::StaticOrder So; So.init(M1, NG1A, 192, F.bid); pg8::EpiBf16 E{ACT, PWP}; pg8::gemm_phase(F.lds, g, So, E); }
        else { pg8::Gemm g{XN, WIN1 + (size_t)NG1A * DM, S, 256, DM}; pg8::StaticOrder So; So.init(S, 256, F.G - 192, F.bid - 192); pg8::EpiBf16 E{ACT + NG1A, PWP}; pg8::gemm_phase(F.lds, g, So, E); }
    }
    SEAM(4);
    if (IN(5)) prep_rwkv(F, a, 0, T1, F.bid, F.G);
    SEAM(5);
    if (IN(6)) {
        unsigned* shw = (unsigned*)(F.ws + WS_CTL + 20480); const int nsh = F.G - 64;
        if (F.bid < 64) { rwkv_scan(F, F.bid, shw, 2u, (M1 / RW_TB - 4) & ~1); xcd_wait(shw, 4u); }
        else {
            { pg8::Gemm g{XN + (size_t)M1 * DM, (const bf16_t*)(F.ws + WS_KV2), S - M1, NG1A, DM}; pg8::StaticOrder So; So.init(S - M1, NG1A, nsh, F.bid - 64); pg8::EpiBf16 E{ACT + (size_t)M1 * PWP, PWP}; pg8::gemm_phase(F.lds, g, So, E); }
            xcd_barrier(xbar2);
            prep_rwkv(F, a, T1, S / 16, F.bid - 64, nsh);
            xcd_barrier(xbar2);
            { pg8::Gemm g{XN, (const bf16_t*)(F.ws + WS_WIN2), S, NG2, DM}; pg8::StaticOrder So; So.init(S, NG2, nsh, F.bid - 64); pg8::EpiBf16 E{ACT + NG1, PWP}; pg8::gemm_phase(F.lds, g, So, E); }
            xcd_barrier(xbar2);
            prep_rope(F, a, F.bid - 64, nsh);
            xcd_barrier(xbar2);
        }
        dsa_phase(F);
    }
#if defined(PROBE_REP6)
    grid.sync(); if (F.bid == 0 && F.tid == 0) *(unsigned*)(F.ws + WS_CTL) = 0u; grid.sync();
#if PROBE_REP6 == 1
    if (IN(6)) { if (F.bid < 64) rwkv_scan(F, F.bid); dsa_phase(F); }
#elif PROBE_REP6 == 2
    if (IN(6)) { if (F.bid < 64) rwkv_scan(F, F.bid); }
#elif PROBE_REP6 == 3
    if (IN(6)) { dsa_phase(F); }
#else
    if (IN(6)) { dsa_phase(F); }
#endif
#endif
    SEAM(6);
    if (IN(7)) post_phase(F, a);
    SEAM(7);
    if (IN(8)) { pg8::Gemm g{XN, WOUT, S, DM, DM}; pg8::StaticOrder So; So.init(S, DM, F.G, F.bid); pg8::EpiResF32 E{a.out, a.out, DM, 1.0f}; pg8::gemm_phase(F.lds, g, So, E); }
    SEAM(8);
    if (IN(9)) {
        convert_weight<1>(F, a.in[25], a.in[26], DM, FF, 2 * FF, WGU);
        convert_weight<0>(F, a.in[27], nullptr, FF, DM, DM, WDN);
        rmsnorm_rows<true>(F, a.out, a.in[24], XN);
    }
    SEAM(9);
    if (IN(10)) { pg8::Gemm g{XN, WGU, S, 2 * FF, DM}; pg8::StaticOrder So; So.init(S, 2 * FF, F.G, F.bid); pg8::EpiSwiglu E{ACT, FF}; pg8::gemm_phase(F.lds, g, So, E); }
    SEAM(10);
    if (IN(11)) { pg8::Gemm g{ACT, WDN, S, DM, FF}; pg8::StaticOrder So; So.init(S, DM, F.G, F.bid); pg8::EpiResF32 E{a.out, a.out, DM, 0.5f}; pg8::gemm_phase(F.lds, g, So, E); }
    SEAM(11);
    if (IN(12)) rmsnorm_rows<false>(F, a.out, a.in[28], a.out);
#undef IN
#undef SEAM
}


#ifndef MK_MULTI
#define MK_MULTI 0
#endif
extern "C" void kernel_launch(void* const* d_in, const int* in_sizes, int n_in, void* d_out, int out_size, void* d_ws, size_t ws_size, hipStream_t stream) {
    static int grid = 0;
    if (grid == 0) {
        if (n_in != 29 || out_size != S * DM || ws_size < WS_END) { fprintf(stderr, "kernel_launch: unexpected shapes n_in %d out %d ws %zu\n", n_in, out_size, ws_size); grid = -1; return; }
        int dev = 0, cus = 0, per_cu = 0;
        (void)hipGetDevice(&dev); (void)hipDeviceGetAttribute(&cus, hipDeviceAttributeMultiprocessorCount, dev);
        if (hipFuncSetAttribute((const void*)fwd_kernel, hipFuncAttributeMaxDynamicSharedMemorySize, LDS_BYTES) != hipSuccess) { fprintf(stderr, "kernel_launch: hipFuncSetAttribute failed\n"); grid = -1; return; }
        (void)hipOccupancyMaxActiveBlocksPerMultiprocessor(&per_cu, (const void*)fwd_kernel, NTHR, LDS_BYTES);
        if (per_cu < 1) per_cu = 1;
        (void)hipGetLastError();
        grid = cus * per_cu;
        fprintf(stderr, "kernel_launch: grid %d (cus %d per_cu %d)\n", grid, cus, per_cu);
    }
    if (grid < 0) return;
    (void)hipMemsetAsync((char*)d_ws + WS_CTL, 0, 65536, stream);
    Args a{};
    for (int i = 0; i < 29; ++i) a.in[i] = (const float*)d_in[i];
    a.out = (float*)d_out; a.ws = (unsigned char*)d_ws;
    for (int i = 0; i < 16; ++i) a.inv32[i] = powf(500000.0f, -((float)i * 2.0f / 32.0f));
    for (int i = 0; i < 8; ++i) a.inv16[i] = powf(500000.0f, -((float)i * 2.0f / 16.0f));
#if MK_MULTI
    for (int p = 0; p < NPHASE; ++p) { a.ph_lo = p; a.ph_hi = p + 1; hipLaunchKernelGGL(fwd_kernel, dim3(grid), dim3(NTHR), LDS_BYTES, stream, a); }
#else
    a.ph_lo = 0; a.ph_hi = NPHASE;
    void* args[] = {&a};
    hipError_t e = hipLaunchCooperativeKernel((const void*)fwd_kernel, dim3(grid), dim3(NTHR), args, LDS_BYTES, stream);
    if (e != hipSuccess) fprintf(stderr, "cooperative launch failed: %s (grid %d)\n", hipGetErrorString(e), grid);
#endif
}
```

```cpp
#include <hip/hip_runtime.h>
#include <hip/hip_cooperative_groups.h>
#include <cstdio>
#include <cstdint>
#include <cmath>
namespace cg = cooperative_groups;

#define LAS __attribute__((address_space(3)))
typedef unsigned short bf16_t;
typedef short bf16x8 __attribute__((ext_vector_type(8)));
typedef float f32x4 __attribute__((ext_vector_type(4)));
typedef float f32x2 __attribute__((ext_vector_type(2)));
typedef float f32x16 __attribute__((ext_vector_type(16)));
typedef unsigned u32x4 __attribute__((ext_vector_type(4)));
typedef unsigned u32x2 __attribute__((ext_vector_type(2)));

constexpr int S = 16384, DM = 2048, FF = 5632, PW = 5384, PWP = 5632;
constexpr int NTHR = 512, NWAVES = 8;
constexpr int URR = 0, URK = 1024, URV = 2048, UWD = 3072, UAD = 3136, UGD = 3200, NG1 = 3328, UQ = 3328, UK = 4352, UV = 4608, UQI = 4864, UKI = 5376, UWI = 5440, NG2 = 2304;
static_assert(NG1 + NG2 == 5632, "in-proj column groups");
constexpr float NORM_EPS = 1e-6f, GN_EPS = 64e-5f;
constexpr size_t MiB = 1u << 20;
constexpr size_t WS_U = 0;
constexpr size_t WS_XN = 176 * MiB;
constexpr size_t WS_WB = 240 * MiB;
constexpr size_t WS_WB2 = 284 * MiB;
constexpr size_t WS_R = 240 * MiB, WS_V = 272 * MiB;
constexpr size_t WS_W = 306 * MiB;
constexpr size_t WS_A = 370 * MiB, WS_B = 402 * MiB, WS_KP = 434 * MiB;
constexpr size_t WS_WOUT = 466 * MiB;
constexpr size_t WS_BR = 474 * MiB, WS_KR = 475 * MiB, WS_BON = 476 * MiB;
constexpr size_t WS_CTL = 477 * MiB;
constexpr size_t WS_KI2 = 478 * MiB;
constexpr size_t WS_KV2 = 480 * MiB;
constexpr size_t WS_WIN2 = 496 * MiB;
constexpr size_t WS_END = 506 * MiB;
constexpr int LDS_BYTES = 163840;

__device__ __forceinline__ unsigned f2bf(float f) { unsigned u = __builtin_bit_cast(unsigned, f); return (u + 0x7fffu + ((u >> 16) & 1u)) >> 16; }
__device__ __forceinline__ unsigned pk2(float lo, float hi) { return f2bf(lo) | (f2bf(hi) << 16); }
__device__ __forceinline__ float bf2f(unsigned b) { return __builtin_bit_cast(float, b << 16); }
__device__ __forceinline__ float bflo(unsigned p) { return __builtin_bit_cast(float, p << 16); }
__device__ __forceinline__ float bfhi(unsigned p) { return __builtin_bit_cast(float, p & 0xffff0000u); }
template <int CTRL> __device__ __forceinline__ float dppf(float v) {
    return __builtin_bit_cast(float, __builtin_amdgcn_update_dpp(0, __builtin_bit_cast(int, v), CTRL, 0xF, 0xF, false));
}
__device__ __forceinline__ float red16(float v) {
    v += dppf<0xB1>(v); v += dppf<0x4E>(v); v += dppf<0x141>(v); v += dppf<0x140>(v); return v;
}

template <int CTRL, int ROWMASK> __device__ __forceinline__ float dppf_m(float oldv, float v) {
    return __builtin_bit_cast(float, __builtin_amdgcn_update_dpp(__builtin_bit_cast(int, oldv), __builtin_bit_cast(int, v), CTRL, ROWMASK, 0xF, false));
}
__device__ __forceinline__ float wave_sum(float v) {
    v += dppf<0xB1>(v); v += dppf<0x4E>(v); v += dppf<0x141>(v); v += dppf<0x140>(v);
    v += dppf_m<0x142, 0xA>(0.f, v);
    v += dppf_m<0x143, 0xC>(0.f, v);
    return __builtin_bit_cast(float, __builtin_amdgcn_readlane(__builtin_bit_cast(int, v), 63));
}
__device__ __forceinline__ float wave_max(float v) {
    v = fmaxf(v, dppf<0xB1>(v)); v = fmaxf(v, dppf<0x4E>(v)); v = fmaxf(v, dppf<0x141>(v)); v = fmaxf(v, dppf<0x140>(v));
    v = fmaxf(v, dppf_m<0x142, 0xA>(v, v));
    v = fmaxf(v, dppf_m<0x143, 0xC>(v, v));
    return __builtin_bit_cast(float, __builtin_amdgcn_readlane(__builtin_bit_cast(int, v), 63));
}
namespace pg8 {
constexpr int BM = 256, BK = 64, HALF = 128, HTB = HALF * BK * 2, STAGE_BYTES = 8 * HTB, NXCD = 8, WGM = 4;
__host__ __device__ __forceinline__ int lds_byte(int r, int c) { const int st = (r >> 4) * 2 + (c >> 5), rr = r & 15, cc = c & 31, ob = rr * 64 + cc * 2; return st * 1024 + (ob ^ (((ob >> 9) & 1) << 5)); }
__host__ __device__ __forceinline__ void stage_rc(int b, int& R, int& C) { const int st = b / 1024, sb = b % 1024, swz = sb ^ (((sb >> 9) & 1) << 5); R = (st >> 1) * 16 + swz / 64; C = (st & 1) * 32 + (swz % 64) / 2; }
__host__ __device__ __forceinline__ int perm32(int rho) { const int n = rho >> 4, i = rho & 15; return 8 * (i >> 2) + 4 * n + (i & 3); }
struct Unit { int pm, pn; };
struct Gemm { const bf16_t* A; const bf16_t* Bt; int M, N, K; };
struct StaticOrder {
    int nM, nN, nwg, G, c;
    __host__ __device__ void init(int M, int N, int G_, int c_) { nM = M / BM; nN = N / BM; nwg = nM * nN; G = G_; c = c_; }
    __host__ __device__ bool next(int i, Unit& u) const {
        const long L = (long)i * G + c; if (L >= nwg) return false;
        int wgid = (int)L; { const int q = nwg / NXCD, r = nwg % NXCD, xcd = wgid % NXCD, off = wgid / NXCD; wgid = (xcd < r ? xcd * (q + 1) : r * (q + 1) + (xcd - r) * q) + off; }
        const int nig = WGM * nN, gid = wgid / nig, fm = gid * WGM, gsz = (nM - fm) < WGM ? (nM - fm) : WGM;
        u.pm = fm + ((wgid % nig) % gsz); u.pn = (wgid % nig) / gsz; return true;
    }
};
__device__ __forceinline__ unsigned cvt_pk_bf16(float lo, float hi) { unsigned r; asm volatile("v_cvt_pk_bf16_f32 %0, %1, %2" : "=v"(r) : "v"(lo), "v"(hi)); return r; }

struct EpiBf16 {
    bf16_t* O; int ldc;
    __device__ __forceinline__ void operator()(const f32x4 (&acc)[2][2][4][2], const Unit& u, int wr, int wc, int fr, int fq) const {
        const int row0 = u.pm * BM + wr * 64 + fr, col0 = u.pn * BM + wc * 32 + 8 * fq;
#pragma unroll
        for (int ai = 0; ai < 2; ++ai)
#pragma unroll
            for (int m = 0; m < 4; ++m) { bf16_t* rowp = O + (size_t)(row0 + ai * HALF + m * 16) * ldc + col0;
#pragma unroll
                for (int bj = 0; bj < 2; ++bj) { const f32x4 v0 = acc[ai][bj][m][0], v1 = acc[ai][bj][m][1];
                    u32x4 w; w.x = cvt_pk_bf16(v0[0], v0[1]); w.y = cvt_pk_bf16(v0[2], v0[3]); w.z = cvt_pk_bf16(v1[0], v1[1]); w.w = cvt_pk_bf16(v1[2], v1[3]);
                    *(u32x4*)(rowp + bj * HALF) = w; } }
    }
};
struct EpiSwiglu {
    bf16_t* O; int ldc;
    __device__ __forceinline__ void operator()(const f32x4 (&acc)[2][2][4][2], const Unit& u, int wr, int wc, int fr, int fq) const {
        const int row0 = u.pm * BM + wr * 64 + fr, col0 = (u.pn * BM + wc * 32) / 2 + 4 * fq;
#pragma unroll
        for (int ai = 0; ai < 2; ++ai)
#pragma unroll
            for (int m = 0; m < 4; ++m) { bf16_t* rowp = O + (size_t)(row0 + ai * HALF + m * 16) * ldc + col0;
#pragma unroll
                for (int bj = 0; bj < 2; ++bj) { const f32x4 g = acc[ai][bj][m][0], up = acc[ai][bj][m][1];
                    float a[4];
#pragma unroll
                    for (int e = 0; e < 4; ++e) a[e] = g[e] * __builtin_amdgcn_rcpf(1.f + __expf(-g[e])) * up[e];
                    u32x2 w; w.x = cvt_pk_bf16(a[0], a[1]); w.y = cvt_pk_bf16(a[2], a[3]);
                    *(u32x2*)(rowp + bj * (HALF / 2)) = w; } }
    }
};
struct EpiResF32 {
    const float* base; float* out; int ldc; float scale;
    __device__ __forceinline__ void operator()(const f32x4 (&acc)[2][2][4][2], const Unit& u, int wr, int wc, int fr, int fq) const {
        const int row0 = u.pm * BM + wr * 64 + fr, col0 = u.pn * BM + wc * 32 + 8 * fq;
#pragma unroll
        for (int ai = 0; ai < 2; ++ai)
#pragma unroll
            for (int m = 0; m < 4; ++m) { const size_t ro = (size_t)(row0 + ai * HALF + m * 16) * ldc + col0;
#pragma unroll
                for (int bj = 0; bj < 2; ++bj) {
                    const f32x4 b0 = *(const f32x4*)(base + ro + bj * HALF), b1 = *(const f32x4*)(base + ro + bj * HALF + 4);
                    *(f32x4*)(out + ro + bj * HALF) = b0 + acc[ai][bj][m][0] * scale;
                    *(f32x4*)(out + ro + bj * HALF + 4) = b1 + acc[ai][bj][m][1] * scale; } }
    }
};

template <class Epi, class Sched>
__device__ __forceinline__ void gemm_phase(LAS unsigned char* lds, const Gemm g, const Sched& S, const Epi& E) {
    const int tid = threadIdx.x, wid = __builtin_amdgcn_readfirstlane(tid >> 6), lane = tid & 63, wr = wid >> 2, wc = wid & 3, fr = lane & 15, fq = lane >> 4;
    const int K = g.K, nt = K / BK;
    unsigned voffA[2], voffB[2];
#pragma unroll
    for (int i = 0; i < 2; ++i) { int R, C; stage_rc(tid * 16 + i * 8192, R, C); const int Rb = (R & ~31) + perm32(R & 31);
        voffA[i] = (unsigned)(R * K + C) * 2u; voffB[i] = (unsigned)(Rb * K + C) * 2u; }
    const size_t kstep = (size_t)(BK * 2);
    const size_t hstep = (size_t)HALF * K * 2;
    const size_t tstep = 2 * hstep;
    const unsigned ldsw = (unsigned)wid * 1024u;
    const int aoff = lds_byte(wr * 64 + fr, fq * 8), boff = lds_byte(wc * 32 + fr, fq * 8);
#define PG8_SA(b, h) (((b) * 2 + (h)) * HTB)
#define PG8_SB(b, h) ((4 + (b) * 2 + (h)) * HTB)
#define PG8_STAGE(bufoff, gbase, voff) do { _Pragma("unroll") for (int _i = 0; _i < 2; ++_i) \
        __builtin_amdgcn_global_load_lds((const unsigned*)((const char*)(gbase) + (voff)[_i]), (LAS unsigned*)(lds + (bufoff) + ldsw + _i * 8192), 16, 0, 0); } while (0)
#define PG8_LDA(dst, b, h) do { _Pragma("unroll") for (int m = 0; m < 4; ++m) _Pragma("unroll") for (int k = 0; k < 2; ++k) dst[m][k] = *(const LAS bf16x8*)(lds + PG8_SA(b, h) + aoff + m * 2048 + k * 1024); } while (0)
#define PG8_LDB(dst, b, h) do { _Pragma("unroll") for (int n = 0; n < 2; ++n) _Pragma("unroll") for (int k = 0; k < 2; ++k) dst[n][k] = *(const LAS bf16x8*)(lds + PG8_SB(b, h) + boff + n * 2048 + k * 1024); } while (0)
#define PG8_MMA(ai, bj, At, Bt) do { __builtin_amdgcn_s_setprio(1); _Pragma("unroll") for (int m = 0; m < 4; ++m) _Pragma("unroll") for (int n = 0; n < 2; ++n) _Pragma("unroll") for (int k = 0; k < 2; ++k) \
        acc[ai][bj][m][n] = __builtin_amdgcn_mfma_f32_16x16x32_bf16(Bt[n][k], At[m][k], acc[ai][bj][m][n], 0, 0, 0); __builtin_amdgcn_s_setprio(0); } while (0)
#define PG8_WAIT_V(n) asm volatile("s_waitcnt vmcnt(" #n ")" ::: "memory")
#define PG8_WAIT_L(n) asm volatile("s_waitcnt lgkmcnt(" #n ")" ::: "memory")
#define PG8_BAR __builtin_amdgcn_s_barrier()
#define PG8_SCHED __builtin_amdgcn_sched_barrier(0)
    Unit cur, nxt; int ui = 0;
    if (!S.next(0, cur)) return;
    f32x4 acc[2][2][4][2];
#pragma unroll
    for (int a = 0; a < 2; ++a)
#pragma unroll
        for (int b = 0; b < 2; ++b)
#pragma unroll
            for (int m = 0; m < 4; ++m)
#pragma unroll
                for (int n = 0; n < 2; ++n) acc[a][b][m][n] = (f32x4){0.f, 0.f, 0.f, 0.f};
    bf16x8 At[4][2], B0[2][2], B1[2][2];
    const char* cA = (const char*)g.A + (size_t)cur.pm * tstep; const char* cB = (const char*)g.Bt + (size_t)cur.pn * tstep;
    PG8_STAGE(PG8_SB(0, 0), cB, voffB); PG8_STAGE(PG8_SB(0, 1), cB + hstep, voffB); PG8_STAGE(PG8_SA(0, 0), cA, voffA); PG8_STAGE(PG8_SA(0, 1), cA + hstep, voffA);
    if (wr == 1) PG8_BAR;
    PG8_WAIT_V(2); PG8_BAR;
    PG8_STAGE(PG8_SB(1, 0), cB + kstep, voffB); PG8_STAGE(PG8_SA(1, 0), cA + kstep, voffA); PG8_STAGE(PG8_SB(1, 1), cB + hstep + kstep, voffB);
    PG8_WAIT_V(6); PG8_BAR;
    for (;;) {
        const bool has_next = S.next(ui + 1, nxt);
        const char* nA = has_next ? (const char*)g.A + (size_t)nxt.pm * tstep : cA; const char* nB = has_next ? (const char*)g.Bt + (size_t)nxt.pn * tstep : cB;
        for (int t = 0; t < nt; t += 2) {
            const bool last = (t == nt - 2);
            const char* a1 = cA + (size_t)(t + 1) * kstep;
            const char* a2 = last ? nA : cA + (size_t)(t + 2) * kstep; const char* b2 = last ? nB : cB + (size_t)(t + 2) * kstep;
            const char* a3 = a2 + kstep; const char* b3 = b2 + kstep;
            PG8_LDB(B0, 0, 0); PG8_LDB(B1, 0, 1); PG8_SCHED; PG8_LDA(At, 0, 0); PG8_STAGE(PG8_SA(1, 1), a1 + hstep, voffA);
            PG8_WAIT_V(8); PG8_WAIT_L(0); PG8_BAR; PG8_MMA(0, 0, At, B0); PG8_MMA(0, 1, At, B1); PG8_BAR; PG8_SCHED;
            PG8_LDA(At, 0, 1); PG8_STAGE(PG8_SB(0, 0), b2, voffB); PG8_STAGE(PG8_SB(0, 1), b2 + hstep, voffB); PG8_STAGE(PG8_SA(0, 0), a2, voffA);
            PG8_WAIT_V(8); PG8_WAIT_L(0); PG8_BAR; PG8_MMA(1, 0, At, B0); PG8_MMA(1, 1, At, B1); PG8_BAR; PG8_SCHED;
            PG8_LDB(B0, 1, 0); PG8_LDB(B1, 1, 1); PG8_SCHED; PG8_LDA(At, 1, 0); PG8_STAGE(PG8_SA(0, 1), a2 + hstep, voffA);
            PG8_WAIT_V(8); PG8_WAIT_L(0); PG8_BAR; PG8_MMA(0, 0, At, B0); PG8_MMA(0, 1, At, B1); PG8_BAR; PG8_SCHED;
            PG8_LDA(At, 1, 1); PG8_STAGE(PG8_SB(1, 0), b3, voffB); PG8_STAGE(PG8_SB(1, 1), b3 + hstep, voffB); PG8_STAGE(PG8_SA(1, 0), a3, voffA);
            PG8_WAIT_V(8); PG8_WAIT_L(0); PG8_BAR; PG8_MMA(1, 0, At, B0); PG8_MMA(1, 1, At, B1); PG8_BAR; PG8_SCHED;
        }
        if (wr == 0) PG8_BAR;
        E(acc, cur, wr, wc, fr, fq);
        if (!has_next) break;
#pragma unroll
        for (int a = 0; a < 2; ++a)
#pragma unroll
            for (int b = 0; b < 2; ++b)
#pragma unroll
                for (int m = 0; m < 4; ++m)
#pragma unroll
                    for (int n = 0; n < 2; ++n) acc[a][b][m][n] = (f32x4){0.f, 0.f, 0.f, 0.f};
        cur = nxt; cA = nA; cB = nB; ++ui;
        if (wr == 1) PG8_BAR;
    }
    PG8_WAIT_V(0);
    PG8_BAR;
#undef PG8_SA
#undef PG8_SB
#undef PG8_STAGE
#undef PG8_LDA
#undef PG8_LDB
#undef PG8_MMA
#undef PG8_WAIT_V
#undef PG8_WAIT_L
#undef PG8_BAR
#undef PG8_SCHED
}
}

struct Args { const float* in[29]; float* out; unsigned char* ws; float inv32[16]; float inv16[8]; int ph_lo, ph_hi; };

struct Frame {
    LAS unsigned char* lds;
    int tid, lane, wave, G, bid;
    unsigned char* ws;
};

#define LDS_WAIT() asm volatile("s_waitcnt lgkmcnt(0)" ::: "memory")

template <int MODE>
__device__ __forceinline__ void transpose_item(const float* W, const float* W2, int K, int Nsrc, int Ndst, bf16_t* WT, LAS float* scr, int item, int lane) {
    const int nblk = Ndst / 64, kb = item / nblk, nb = item % nblk, k0 = 64 * kb, n0 = 64 * nb;
    const int c4 = lane & 15, r4 = lane >> 4;
    const float* src; bool ok = true; int lcol;
    if (MODE == 0) { src = W + n0 + 4 * c4; ok = (n0 + 4 * c4) < Nsrc; lcol = 4 * c4; }
    else if (MODE == 2) {
        const int n = n0 + 4 * c4; int sc = -1; if (n < 3264) sc = 2120 + n; else if (n >= 3328 && n < 3328 + 2120) sc = n - 3328;
        ok = sc >= 0; src = W + (ok ? sc : 0); lcol = 4 * c4; }
    else if (MODE == 3) { const int n = n0 + 4 * c4; ok = n < 2120; src = W + (ok ? n : 0); lcol = 4 * c4; }
    else { const int t = c4 >> 3, g = c4 & 7; src = (t ? W2 : W) + n0 / 2 + 4 * g; lcol = 8 * g + 4 * t; }
    f32x4 v[16];
#pragma unroll
    for (int i = 0; i < 16; ++i) v[i] = ok ? *(const f32x4*)(src + (size_t)(k0 + 4 * i + r4) * Nsrc) : (f32x4){0.f, 0.f, 0.f, 0.f};
#pragma unroll
    for (int i = 0; i < 16; ++i) { LAS float* d = scr + (4 * i + r4) * 65 + lcol; d[0] = v[i].x; d[1] = v[i].y; d[2] = v[i].z; d[3] = v[i].w; }
    LDS_WAIT(); asm volatile("" ::: "memory");
    const int c = lane & 7;
#pragma unroll
    for (int j = 0; j < 8; ++j) { const int n = (lane >> 3) + 8 * j; const LAS float* sp = scr + (8 * c) * 65 + n;
        u32x4 o; o.x = pk2(sp[0 * 65], sp[1 * 65]); o.y = pk2(sp[2 * 65], sp[3 * 65]); o.z = pk2(sp[4 * 65], sp[5 * 65]); o.w = pk2(sp[6 * 65], sp[7 * 65]);
        *(u32x4*)(WT + (size_t)(n0 + n) * K + k0 + 8 * c) = o; }
    LDS_WAIT(); asm volatile("" ::: "memory");
}
template <int MODE>
__device__ __forceinline__ void convert_weight(Frame& F, const float* W, const float* W2, int K, int Nsrc, int Ndst, bf16_t* WT) {
    LAS float* scr = (LAS float*)(F.lds + F.wave * 17408);
    const int gw = F.bid * NWAVES + F.wave, NGW = F.G * NWAVES, nitems = (K / 64) * (Ndst / 64);
    for (int it = gw; it < nitems; it += NGW) transpose_item<MODE>(W, W2, K, Nsrc, Ndst, WT, scr, it, F.lane);
}
template <bool OUT_BF16>
__device__ __forceinline__ void rmsnorm_rows(Frame& F, const float* X, const float* gain, void* O) {
    const int gw = F.bid * NWAVES + F.wave, NGW = F.G * NWAVES;
    f32x4 gv[8];
#pragma unroll
    for (int j = 0; j < 8; ++j) gv[j] = ((const f32x4*)gain)[F.lane + 64 * j];
    for (int m = gw; m < S; m += NGW) {
        const f32x4* xr = (const f32x4*)(X + (size_t)m * DM) + F.lane;
        f32x4 v[8]; float s = 0.f;
#pragma unroll
        for (int j = 0; j < 8; ++j) { v[j] = xr[64 * j]; s += (v[j].x * v[j].x + v[j].y * v[j].y) + (v[j].z * v[j].z + v[j].w * v[j].w); }
        const float rs = 1.f / sqrtf(wave_sum(s) * (1.f / DM) + NORM_EPS);
        if (OUT_BF16) {
            u32x2* o8 = (u32x2*)((bf16_t*)O + (size_t)m * DM) + F.lane;
#pragma unroll
            for (int j = 0; j < 8; ++j) { u32x2 w; w.x = pk2(v[j].x * rs * gv[j].x, v[j].y * rs * gv[j].y); w.y = pk2(v[j].z * rs * gv[j].z, v[j].w * rs * gv[j].w); o8[64 * j] = w; }
        } else {
            f32x4* o = (f32x4*)((float*)O + (size_t)m * DM) + F.lane;
#pragma unroll
            for (int j = 0; j < 8; ++j) o[64 * j] = v[j] * rs * gv[j];
        }
    }
}

#define XB_TMO      128
#define XB_XCNT(j)  (256  + 64 * (j))
#define XB_XSUB(j)  (1280 + 64 * (j))
#define XB_XGEN(j)  (2304 + 64 * (j))
#define XB_TOP      3328
#define XB_TOPGEN   3392
#define XCD_BAR_WORDS 3456
#define XB_SPIN_CAP (1u << 18)

__device__ __forceinline__ unsigned xb_ld(unsigned* p)              { return __hip_atomic_load(p, __ATOMIC_RELAXED, __HIP_MEMORY_SCOPE_AGENT); }
__device__ __forceinline__ unsigned xb_add(unsigned* p, unsigned v) { return __hip_atomic_fetch_add(p, v, __ATOMIC_RELAXED, __HIP_MEMORY_SCOPE_AGENT); }
__device__ __forceinline__ unsigned xb_xcc_id() { return (unsigned)__builtin_amdgcn_s_getreg((3 << 11) | 20) & 0xFu; }
#define XB_SPIN(cond, bar) do { unsigned _sp = 0; while (cond) { __builtin_amdgcn_s_sleep(1); \
    if ((++_sp & 255u) == 0u) { if (xb_ld(&(bar)[XB_TMO])) break; if (_sp > XB_SPIN_CAP) { atomicAdd(&(bar)[XB_TMO], 1u); break; } } } } while (0)

struct XcdBarrier {
    unsigned* bar; unsigned x; unsigned G;
    volatile LAS unsigned* st;
};

__device__ __forceinline__ XcdBarrier xcd_barrier_post(unsigned* bar, volatile LAS unsigned* st, unsigned G, bool participate) {
    XcdBarrier b; b.bar = bar; b.x = xb_xcc_id(); b.st = st; b.G = G;
    if (participate && threadIdx.x == 0) (void)xb_add(&bar[XB_XCNT(b.x)], 1u);
    return b;
}
__device__ __forceinline__ void xcd_barrier_complete(unsigned* bar, unsigned x, unsigned& nloc, unsigned& nx, const unsigned G) {
    unsigned sum, cnt, mine, sp = 0u;
    for (;;) {
        sum = 0u; cnt = 0u; mine = 0u;
#pragma unroll
        for (unsigned j = 0; j < 16; ++j) { const unsigned c = xb_ld(&bar[XB_XCNT(j)]); sum += c; cnt += (c > 0u) ? 1u : 0u; mine = (j == x) ? c : mine; }
        if (sum == G) break;
        __builtin_amdgcn_s_sleep(1);
        if ((++sp & 255u) == 0u) { if (xb_ld(&bar[XB_TMO])) break; if (sp > XB_SPIN_CAP) { atomicAdd(&bar[XB_TMO], 1u); break; } }
    }
    nloc = mine > 0u ? mine : 1u; nx = cnt > 0u ? cnt : 1u;
}

__device__ __forceinline__ void xcd_barrier(const XcdBarrier& b) {
    asm volatile("s_waitcnt vmcnt(0)" ::: "memory");
    __syncthreads();
    if (threadIdx.x == 0) {
        unsigned* bar = b.bar;
        __builtin_amdgcn_s_waitcnt(0);
        unsigned nloc = b.st[0], nx = b.st[1];
        if (nloc == 0u) { xcd_barrier_complete(bar, b.x, nloc, nx, b.G); b.st[0] = nloc; b.st[1] = nx; }
        const unsigned old = xb_add(&bar[XB_XSUB(b.x)], 1u);
        const unsigned gen = old / nloc;
        if (old + 1u == (gen + 1u) * nloc) {
            __builtin_amdgcn_fence(__ATOMIC_RELEASE, "agent");
            asm volatile("s_waitcnt vmcnt(0)" ::: "memory");
            const unsigned og = xb_add(&bar[XB_TOP], 1u);
            const unsigned tg = og / nx;
            if (og + 1u == (tg + 1u) * nx) xb_add(&bar[XB_TOPGEN], 1u);
            else XB_SPIN(xb_ld(&bar[XB_TOPGEN]) == tg, bar);
            __builtin_amdgcn_fence(__ATOMIC_ACQUIRE, "agent");
            xb_add(&bar[XB_XGEN(b.x)], 1u);
            asm volatile("s_waitcnt vmcnt(0)" ::: "memory");
        } else {
            XB_SPIN(xb_ld(&bar[XB_XGEN(b.x)]) == gen, bar);
            __builtin_amdgcn_fence(__ATOMIC_ACQUIRE, "agent");
            asm volatile("s_waitcnt vmcnt(0)" ::: "memory");
        }
    }
    __syncthreads();
}

__device__ __forceinline__ void xcd_wait(unsigned* bar, unsigned k) {
    __syncthreads();
    if (threadIdx.x == 0) {
        XB_SPIN(xb_ld(&bar[XB_TOPGEN]) < k, bar);
        __builtin_amdgcn_fence(__ATOMIC_ACQUIRE, "agent");
        asm volatile("s_waitcnt vmcnt(0)" ::: "memory");
    }
    __syncthreads();
}
__device__ __forceinline__ void shadow_barrier(unsigned* ctr, unsigned target, bool arrive) {
    __syncthreads();
    if (threadIdx.x == 0) {
        __threadfence();
        if (arrive) __hip_atomic_fetch_add(ctr, 1u, __ATOMIC_RELAXED, __HIP_MEMORY_SCOPE_AGENT);
        while (__hip_atomic_load(ctr, __ATOMIC_RELAXED, __HIP_MEMORY_SCOPE_AGENT) < target) __builtin_amdgcn_s_sleep(2);
        __threadfence();
    }
    __syncthreads();
}
__device__ __forceinline__ float sigmoidf_(float x) { return 1.f / (1.f + __expf(-x)); }
__device__ __forceinline__ void rope_pair(bf16_t* p, int half, int i, float ang_rev) {
    const float sn = __builtin_amdgcn_sinf(ang_rev), cs = __builtin_amdgcn_cosf(ang_rev);
    const float x1 = bf2f(p[i]), x2 = bf2f(p[i + half]);
    p[i] = (bf16_t)f2bf(x1 * cs - x2 * sn); p[i + half] = (bf16_t)f2bf(x2 * cs + x1 * sn);
}
__device__ __forceinline__ float half_sum(float v, bool upper) {
    v += dppf<0xB1>(v); v += dppf<0x4E>(v); v += dppf<0x141>(v); v += dppf<0x140>(v);
    v += dppf_m<0x142, 0xA>(0.f, v);
    const float s31 = __builtin_bit_cast(float, __builtin_amdgcn_readlane(__builtin_bit_cast(int, v), 31));
    const float s63 = __builtin_bit_cast(float, __builtin_amdgcn_readlane(__builtin_bit_cast(int, v), 63));
    return upper ? s63 : s31;
}
__device__ __forceinline__ void prep_rwkv(Frame& F, const Args& a, int tile_lo, int tile_hi, int idx, int nwg) {
    bf16_t* U = (bf16_t*)(F.ws + WS_U);
    const float *mu_r = a.in[8], *mu_k = a.in[9], *mu_v = a.in[10], *mu_w = a.in[11], *mu_a = a.in[12];
    const float *w0 = a.in[14], *w2 = a.in[15], *a0 = a.in[16], *a2 = a.in[17], *k_k = a.in[19], *k_a = a.in[20], *r_k = a.in[21];
    float* Wd = (float*)(F.ws + WS_W); bf16_t* Ab = (bf16_t*)(F.ws + WS_A); bf16_t* Bb = (bf16_t*)(F.ws + WS_B); bf16_t* Kp = (bf16_t*)(F.ws + WS_KP);
    bf16_t* Rb = (bf16_t*)(F.ws + WS_R); bf16_t* Vb = (bf16_t*)(F.ws + WS_V);
    float* BR = (float*)(F.ws + WS_BR); float* KR = (float*)(F.ws + WS_KR); float* BON = (float*)(F.ws + WS_BON);
    LAS float* xw = (LAS float*)F.lds;
    LAS float* xa = xw + 16 * 64;
    constexpr int TT = 16;
    const int c0 = 2 * F.tid;
    const bool upper = (F.lane & 32) != 0; const int hd = 2 * F.wave + (upper ? 1 : 0);
    const f32x2 mr = *(const f32x2*)(mu_r + c0), mk = *(const f32x2*)(mu_k + c0), mv = *(const f32x2*)(mu_v + c0);
    const f32x2 w0v = *(const f32x2*)(w0 + c0), a0v = *(const f32x2*)(a0 + c0), kkv = *(const f32x2*)(k_k + c0), kav = *(const f32x2*)(k_a + c0), rkv = *(const f32x2*)(r_k + c0);
    for (int tile = tile_lo + idx; tile < tile_hi; tile += nwg) {
        const int t0 = tile * TT;
        __syncthreads();
        for (int e = F.tid; e < TT * 128; e += NTHR) {
            const int tt = e >> 7, d = e & 127, t = t0 + tt; const int col = (d < 64) ? (UWD + d) : (UAD + d - 64);
            const float cur = bf2f(U[(size_t)t * PWP + col]); const float prv = t > 0 ? bf2f(U[(size_t)(t - 1) * PWP + col]) : 0.f;
            const float mu = (d < 64) ? mu_w[d] : mu_a[d - 64];
            const float x = cur + (prv - cur) * mu;
            if (d < 64) xw[tt * 64 + d] = tanhf(x); else xa[tt * 64 + d - 64] = x;
        }
        __syncthreads();
        f32x2 lw[TT], la[TT];
#pragma unroll
        for (int tt = 0; tt < TT; ++tt) { lw[tt] = (f32x2){0.f, 0.f}; la[tt] = (f32x2){0.f, 0.f}; }
        for (int d = 0; d < 64; d += 4) {
            f32x2 ww[4], aa[4];
#pragma unroll
            for (int q = 0; q < 4; ++q) { ww[q] = *(const f32x2*)(w2 + (d + q) * 1024 + c0); aa[q] = *(const f32x2*)(a2 + (d + q) * 1024 + c0); }
#pragma unroll
            for (int tt = 0; tt < TT; ++tt) {
                const f32x4 xv = *(const LAS f32x4*)(xw + tt * 64 + d), av = *(const LAS f32x4*)(xa + tt * 64 + d);
#pragma unroll
                for (int q = 0; q < 4; ++q) { lw[tt] += ww[q] * xv[q]; la[tt] += aa[q] * av[q]; }
            }
        }
        LAS float* lwl = xa + 16 * 64;
        LAS float* lal = lwl + 16 * 1024;
#pragma unroll
        for (int tt = 0; tt < TT; ++tt) { *(LAS f32x2*)(lwl + tt * 1024 + c0) = lw[tt]; *(LAS f32x2*)(lal + tt * 1024 + c0) = la[tt]; }
        unsigned prr = 0u, prk = 0u, prv = 0u;
        if (t0 > 0) { const bf16_t* up = U + (size_t)(t0 - 1) * PWP; prr = *(const unsigned*)(up + URR + c0); prk = *(const unsigned*)(up + URK + c0); prv = *(const unsigned*)(up + URV + c0); }
#pragma unroll 2
        for (int tt = 0; tt < TT; ++tt) {
            const int t = t0 + tt; const bf16_t* ur = U + (size_t)t * PWP;
            const unsigned crr = *(const unsigned*)(ur + URR + c0), crk = *(const unsigned*)(ur + URK + c0), crv = *(const unsigned*)(ur + URV + c0);
            const f32x2 rc = {bflo(crr), bfhi(crr)}, kc = {bflo(crk), bfhi(crk)}, vc = {bflo(crv), bfhi(crv)};
            const f32x2 rp = {bflo(prr), bfhi(prr)}, kp = {bflo(prk), bfhi(prk)}, vp = {bflo(prv), bfhi(prv)};
            prr = crr; prk = crk; prv = crv;
            const f32x2 r = rc + (rp - rc) * mr, k = kc + (kp - kc) * mk, v = vc + (vp - vc) * mv;
            const f32x2 zw = w0v + *(const LAS f32x2*)(lwl + tt * 1024 + c0);
            const f32x2 za = a0v + *(const LAS f32x2*)(lal + tt * 1024 + c0);
            f32x2 decay, alpha;
#pragma unroll
            for (int e = 0; e < 2; ++e) {
                const float nz = -zw[e]; const float sp = fmaxf(nz, 0.f) + log1pf(__expf(-fabsf(nz)));
                decay[e] = __expf(-__expf(-sp - 0.5f)); alpha[e] = sigmoidf_(za[e]); }
            f32x2 kk = k * kkv;
            const float nrm = sqrtf(half_sum(kk.x * kk.x + kk.y * kk.y, upper));
            const float inv = 1.f / fmaxf(nrm, 1e-12f); kk = kk * inv;
            const f32x2 kmod = k * (1.f + (alpha - 1.f) * kav);
            const f32x2 bb = kk * alpha;
            const float br = half_sum(bb.x * r.x + bb.y * r.y, upper), kr = half_sum(kmod.x * r.x + kmod.y * r.y, upper);
            const float bon = half_sum(r.x * kmod.x * rkv.x + r.y * kmod.y * rkv.y, upper);
            const size_t o = (size_t)t * 1024 + c0;
            *(f32x2*)(Wd + o) = decay;
            *(unsigned*)(Ab + o) = pk2(-kk.x, -kk.y); *(unsigned*)(Bb + o) = pk2(bb.x, bb.y); *(unsigned*)(Kp + o) = pk2(kmod.x, kmod.y);
            *(unsigned*)(Rb + o) = pk2(r.x, r.y); *(unsigned*)(Vb + o) = pk2(v.x, v.y);
            if ((F.lane & 31) == 0) { BR[t * 16 + hd] = br; KR[t * 16 + hd] = kr; BON[t * 16 + hd] = bon; }
        }
    }
}
__device__ __forceinline__ void prep_rope(Frame& F, const Args& a, int idx, int nwg) {
    bf16_t* U = (bf16_t*)(F.ws + WS_U);
    constexpr int TT = 16;
    for (int tile = idx; tile < S / TT; tile += nwg) {
        const int t0 = tile * TT;
        for (int e = F.tid; e < TT * 232; e += NTHR) {
            const int tt = e / 232, p = e % 232, t = t0 + tt;
            bf16_t* ur = U + (size_t)t * PWP;
            int base, half, i; float invf;
            if (p < 160) { const int hd = p >> 4; i = p & 15; half = 16; base = (hd < 8) ? (UQ + 128 * hd) : (UK + 128 * (hd - 8)); invf = a.inv32[i]; }
            else { const int q = p - 160, hd = q >> 3; i = q & 7; half = 8; base = (hd < 8) ? (UQI + 64 * hd) : UKI; invf = a.inv16[i]; }
            const float ang = (float)t * invf;
            const double rev = (double)ang * 0.15915494309189535;
            const float fr = (float)(rev - rint(rev));
            rope_pair(ur + base, half, i, fr);
            if (p >= 224) { bf16_t* k2 = (bf16_t*)(F.ws + WS_KI2) + (size_t)t * 64; k2[i] = ur[UKI + i]; k2[i + 8] = ur[UKI + i + 8]; }
            if (p >= 128 && p < 160) { const int gg = (p >> 4) - 8; bf16_t* k2 = (bf16_t*)(F.ws + WS_KV2) + ((size_t)t * 2 + gg) * 256; k2[i] = ur[UK + 128 * gg + i]; k2[i + 16] = ur[UK + 128 * gg + i + 16]; }
        }
        for (int e = F.tid; e < TT * 224; e += NTHR) {
            const int tt = e / 224, r = e % 224, gg = r / 112, c2 = r % 112, t = t0 + tt;
            unsigned* dst = (unsigned*)((bf16_t*)(F.ws + WS_KV2) + ((size_t)t * 2 + gg) * 256);
            if (c2 < 48) dst[16 + c2] = ((const unsigned*)(U + (size_t)t * PWP + UK + 128 * gg + 32))[c2];
            else dst[64 + (c2 - 48)] = ((const unsigned*)(U + (size_t)t * PWP + UV + 128 * gg))[c2 - 48];
        }
        for (int e = F.tid; e < TT * 24; e += NTHR) {
            const int tt = e / 24, c2 = e % 24, t = t0 + tt;
            ((unsigned*)((bf16_t*)(F.ws + WS_KI2) + (size_t)t * 64 + 16))[c2] = ((const unsigned*)(U + (size_t)t * PWP + UKI + 16))[c2];
        }
    }
}

constexpr int RW_TB = 32, RW_REC = 384;
struct RwOps { f32x4 w, a, b, k, wr, vs; };
__device__ __forceinline__ void rwkv_scan(Frame& F, int wg, unsigned* shw, unsigned wait_target, int wait_blk) {
    const int h = wg >> 2, rq = wg & 3;
    const float* Wd = (const float*)(F.ws + WS_W); const bf16_t* Ab = (const bf16_t*)(F.ws + WS_A); const bf16_t* Bb = (const bf16_t*)(F.ws + WS_B); const bf16_t* Kp = (const bf16_t*)(F.ws + WS_KP);
    const bf16_t* Rb = (const bf16_t*)(F.ws + WS_R); const bf16_t* Vb = (const bf16_t*)(F.ws + WS_V);
    const float* BR = (const float*)(F.ws + WS_BR); const float* KR = (const float*)(F.ws + WS_KR);
    LAS float* buf = (LAS float*)F.lds;
    const bool loader = F.wave >= 4;
    const int lt = F.tid - 256, lstep = lt >> 3, part = lt & 7;
    struct LdRegs { f32x4 w0, w1; u32x4 a, b, k, r, v; float br, kr; };
    auto gload = [&](LdRegs& L, int blk) {
        const int t = blk * RW_TB + lstep; const size_t o = (size_t)t * 1024 + h * 64 + 8 * part;
        L.w0 = *(const f32x4*)(Wd + o); L.w1 = *(const f32x4*)(Wd + o + 4);
        L.a = *(const u32x4*)(Ab + o); L.b = *(const u32x4*)(Bb + o); L.k = *(const u32x4*)(Kp + o); L.r = *(const u32x4*)(Rb + o);
        if (part < 2) { L.v = *(const u32x4*)(Vb + (size_t)t * 1024 + h * 64 + 16 * rq + 8 * part); L.br = BR[t * 16 + h]; L.kr = KR[t * 16 + h]; }
    };
    auto lstore = [&](const LdRegs& L, int b) {
        LAS float* rec = buf + (b * RW_TB + lstep) * RW_REC;
        const u32x4 av = L.a, bv = L.b, kv = L.k, rv = L.r;
        f32x4 a_0 = {bflo(av.x), bfhi(av.x), bflo(av.y), bfhi(av.y)}, a_1 = {bflo(av.z), bfhi(av.z), bflo(av.w), bfhi(av.w)};
        f32x4 b_0 = {bflo(bv.x), bfhi(bv.x), bflo(bv.y), bfhi(bv.y)}, b_1 = {bflo(bv.z), bfhi(bv.z), bflo(bv.w), bfhi(bv.w)};
        f32x4 k_0 = {bflo(kv.x), bfhi(kv.x), bflo(kv.y), bfhi(kv.y)}, k_1 = {bflo(kv.z), bfhi(kv.z), bflo(kv.w), bfhi(kv.w)};
        f32x4 r_0 = {bflo(rv.x), bfhi(rv.x), bflo(rv.y), bfhi(rv.y)}, r_1 = {bflo(rv.z), bfhi(rv.z), bflo(rv.w), bfhi(rv.w)};
        *(LAS f32x4*)(rec + 8 * part) = L.w0; *(LAS f32x4*)(rec + 8 * part + 4) = L.w1;
        *(LAS f32x4*)(rec + 64 + 8 * part) = a_0; *(LAS f32x4*)(rec + 64 + 8 * part + 4) = a_1;
        *(LAS f32x4*)(rec + 128 + 8 * part) = b_0; *(LAS f32x4*)(rec + 128 + 8 * part + 4) = b_1;
        *(LAS f32x4*)(rec + 192 + 8 * part) = k_0; *(LAS f32x4*)(rec + 192 + 8 * part + 4) = k_1;
        *(LAS f32x4*)(rec + 256 + 8 * part) = L.w0 * r_0; *(LAS f32x4*)(rec + 256 + 8 * part + 4) = L.w1 * r_1;
        if (part < 2) { const u32x4 vv = L.v;
            const float v8[8] = {bflo(vv.x), bfhi(vv.x), bflo(vv.y), bfhi(vv.y), bflo(vv.z), bfhi(vv.z), bflo(vv.w), bfhi(vv.w)};
#pragma unroll
            for (int e = 0; e < 8; ++e) *(LAS f32x4*)(rec + 320 + (8 * part + e) * 4) = (f32x4){v8[e], v8[e] * L.kr, L.br, 0.f}; }
    };
    LdRegs L0, L1;
    __syncthreads();
    if (loader) { gload(L0, 0); lstore(L0, 0); gload(L0, 1); gload(L1, 2); }
    __syncthreads();
    const int rg = F.lane >> 4, j = F.lane & 15, row = 16 * rq + 4 * F.wave + rg;
    f32x4 st = {0.f, 0.f, 0.f, 0.f};
    unsigned char* Ub = F.ws + WS_U;
    const bool odd1 = (j & 1) != 0, odd2 = (j & 2) != 0;
    constexpr int NBLK = S / RW_TB;
    auto scan_block = [&](int blk) {
            const LAS float* rb = buf + ((blk & 1) * RW_TB) * RW_REC + 4 * j;
            const LAS float* rv_ = buf + ((blk & 1) * RW_TB) * RW_REC + 320 + (4 * F.wave + rg) * 4;
#define RW_LD(R, st_) do { const int off_ = (st_) * RW_REC; R.w = *(const LAS f32x4*)(rb + off_); R.a = *(const LAS f32x4*)(rb + off_ + 64); R.b = *(const LAS f32x4*)(rb + off_ + 128); \
                R.k = *(const LAS f32x4*)(rb + off_ + 192); R.wr = *(const LAS f32x4*)(rb + off_ + 256); R.vs = *(const LAS f32x4*)(rv_ + off_); } while (0)
            RwOps R[4];
            RW_LD(R[0], 0); RW_LD(R[1], 1); RW_LD(R[2], 2);
            for (int s4 = 0; s4 < RW_TB; s4 += 4) {
                float pz[4], u[4];
#pragma unroll
                for (int q = 0; q < 4; ++q) {
                    RW_LD(R[(q + 3) & 3], s4 + q + 3);
                    const RwOps& cur = R[q];
                    const f32x2 slo = {st.x, st.y}, shi = {st.z, st.w};
                    f32x2 ma = slo * (f32x2){cur.a.x, cur.a.y}; ma = __builtin_elementwise_fma(shi, (f32x2){cur.a.z, cur.a.w}, ma);
                    f32x2 mz = slo * (f32x2){cur.wr.x, cur.wr.y}; mz = __builtin_elementwise_fma(shi, (f32x2){cur.wr.z, cur.wr.w}, mz);
                    float psa = ma.x + ma.y; pz[q] = mz.x + mz.y;
                    const f32x2 vb = {cur.vs.x, cur.vs.x};
                    f32x2 tlo = (f32x2){cur.k.x, cur.k.y} * vb, thi = (f32x2){cur.k.z, cur.k.w} * vb;
                    tlo = __builtin_elementwise_fma(slo, (f32x2){cur.w.x, cur.w.y}, tlo); thi = __builtin_elementwise_fma(shi, (f32x2){cur.w.z, cur.w.w}, thi);
                    psa = red16(psa);
                    const f32x2 pb = {psa, psa};
                    tlo = __builtin_elementwise_fma((f32x2){cur.b.x, cur.b.y}, pb, tlo); thi = __builtin_elementwise_fma((f32x2){cur.b.z, cur.b.w}, pb, thi);
                    st = (f32x4){tlo.x, tlo.y, thi.x, thi.y};
                    u[q] = psa * cur.vs.z + cur.vs.y;
                }
                const float qa = (odd1 ? pz[1] : pz[0]) + dppf<0xB1>(odd1 ? pz[0] : pz[1]);
                const float qb = (odd1 ? pz[3] : pz[2]) + dppf<0xB1>(odd1 ? pz[2] : pz[3]);
                float r = (odd2 ? qb : qa) + dppf<0x4E>(odd2 ? qa : qb);
                r += dppf<0x124>(r); r += dppf<0x128>(r);
                const float us = odd2 ? (odd1 ? u[3] : u[2]) : (odd1 ? u[1] : u[0]);
                if (j < 4) { const int t = blk * RW_TB + s4 + j; ((float*)(Ub + (size_t)t * (PWP * 2) + URR * 2))[h * 64 + row] = r + us; }
            }
    };
    for (int blk = 0; blk < NBLK; blk += 2) {
        if (blk == wait_blk) xcd_wait(shw, wait_target);
        if (loader) { lstore(L0, 1); if (blk + 3 < NBLK) gload(L0, blk + 3); }
        else scan_block(blk);
        __syncthreads();
        if (loader) { if (blk + 2 < NBLK) { lstore(L1, 0); if (blk + 4 < NBLK) gload(L1, blk + 4); } }
        else scan_block(blk + 1);
        __syncthreads();
    }
}

constexpr int DSA_CAP = 640;
constexpr int DW_SC = 0, DW_IX = 4 * DSA_CAP * 4  , DW_P = DW_IX + 4 * DSA_CAP * 2  , DW_BYTES = DW_P + 4096  ;
static_assert(8 * DW_BYTES <= LDS_BYTES, "dsa lds");
typedef short v4i16_t __attribute__((ext_vector_type(4)));
__device__ __forceinline__ unsigned ukey(float f) { const unsigned b = __builtin_bit_cast(unsigned, f); return (b & 0x80000000u) ? ~b : (b | 0x80000000u); }
__device__ __forceinline__ float ukey_inv(unsigned k) { const unsigned b = (k & 0x80000000u) ? (k & 0x7fffffffu) : ~k; return __builtin_bit_cast(float, b); }
__device__ __forceinline__ int popc64(unsigned long long m) { return __builtin_popcountll(m); }
__device__ __forceinline__ int lanes_below(unsigned long long m) { return __builtin_amdgcn_mbcnt_hi((unsigned)(m >> 32), __builtin_amdgcn_mbcnt_lo((unsigned)m, 0u)); }

__device__ __forceinline__ float dsa_compact(const bool EXACT, LAS float* scl, LAS unsigned short* ixl, int n, int lane, int& ncnt) {
    float e[10]; unsigned x[10], uk[10];
#pragma unroll
    for (int i = 0; i < 10; ++i) { const int p = lane + 64 * i; const bool v = p < n; e[i] = v ? scl[p] : -INFINITY; x[i] = v ? ixl[p] : 0u; uk[i] = v ? ukey(e[i]) : 0u; }
    unsigned prefix = 0u;
    const int lowbit = EXACT ? 0 : 14;
    for (int bit = 31; bit >= lowbit; --bit) {
        const unsigned trial = prefix | (1u << bit); int c = 0;
#pragma unroll
        for (int i = 0; i < 10; ++i) c += popc64(__ballot(uk[i] >= trial));
        if (c >= 256) prefix = trial;
    }
    int need = 1 << 30;
    if (EXACT) { int cgt = 0;
#pragma unroll
        for (int i = 0; i < 10; ++i) cgt += popc64(__ballot(uk[i] > prefix));
        need = 256 - cgt; }
    int base = 0, tseen = 0;
#pragma unroll
    for (int i = 0; i < 10; ++i) {
        const bool gt = uk[i] > prefix, eq = uk[i] == prefix;
        const unsigned long long meq = __ballot(eq); const bool keep = gt || (eq && (tseen + lanes_below(meq)) < need); tseen += popc64(meq);
        const unsigned long long mk = __ballot(keep);
        if (keep) { const int pos = base + lanes_below(mk); scl[pos] = e[i]; ixl[pos] = (unsigned short)x[i]; }
        base += popc64(mk);
    }
    ncnt = base;
    return ukey_inv(prefix);
}

__device__ __forceinline__ void dsa_phase(Frame& F) {
    const bf16_t* U = (const bf16_t*)(F.ws + WS_U);
    const bf16_t* KI2 = (const bf16_t*)(F.ws + WS_KI2);
    const bf16_t* KV2 = (const bf16_t*)(F.ws + WS_KV2);
    bf16_t* MIX = (bf16_t*)(F.ws + WS_XN);
    unsigned* ctr = (unsigned*)(F.ws + WS_CTL);
    const int lane = F.lane, w = F.wave;
    LAS unsigned char* wl = F.lds + w * DW_BYTES;
    LAS float* scb = (LAS float*)(wl + DW_SC);
    LAS unsigned short* ixb = (LAS unsigned short*)(wl + DW_IX);
    LAS float* Pw = (LAS float*)(wl + DW_P);
    LAS unsigned short* Pb = (LAS unsigned short*)(wl + DW_P);
    LAS unsigned char* vst = wl + DW_SC;
    const int g5 = lane >> 5, n32 = lane & 31;
    for (;;) {
        unsigned item = 0u;
        if (lane == 0) item = atomicAdd(ctr, 1u);
        item = (unsigned)__builtin_amdgcn_readfirstlane((int)item);
        if (item >= 4096u) break;
        const int tq0 = (4095 - (int)item) * 4, ch = tq0 >> 6, nkb = ch + 1;
        bf16x8 afr[4];
        { const int rho = n32, b = rho >> 3, g = (rho >> 2) & 1, r = rho & 3, qq = 2 * g + (b >> 1), hh = 4 * (b & 1) + r;
          const bf16_t* src = U + (size_t)(tq0 + qq) * PWP + UQI + 64 * hh + 8 * g5;
#pragma unroll
          for (int ks = 0; ks < 4; ++ks) afr[ks] = *(const bf16x8*)(src + 16 * ks); }
        float wgt[16];
#pragma unroll
        for (int i = 0; i < 16; ++i) { const int qq = 2 * g5 + (i >> 3), hh = 4 * ((i >> 2) & 1) + (i & 3); wgt[i] = bf2f(U[(size_t)(tq0 + qq) * PWP + UWI + hh]) * 0.044194173824159216f; }
        int cnt0 = 0, cnt1 = 0, cnt2 = 0, cnt3 = 0;
        float tau0 = -INFINITY, tau1 = -INFINITY;
        const bf16_t* kbase = KI2 + (size_t)n32 * 64 + 8 * g5;
#define DSA_LOADB(B, kb_) do { _Pragma("unroll") for (int cb_ = 0; cb_ < 2; ++cb_) _Pragma("unroll") for (int ks_ = 0; ks_ < 4; ++ks_) \
            B[cb_][ks_] = *(const bf16x8*)(kbase + (size_t)(kb_) * 4096 + cb_ * 2048 + ks_ * 16); } while (0)
#define DSA_COMPACT_ALL(FIN, SCHED) do { _Pragma("unroll 1") for (int ql_ = 0; ql_ < 4; ++ql_) { \
            int c_ = (ql_ == 0) ? cnt0 : (ql_ == 1) ? cnt1 : (ql_ == 2) ? cnt2 : cnt3; \
            int mode_ = (FIN) ? (c_ > 256 ? 2 : 0) : ((c_ > 512) ? 1 : 0); \
            float thr_ = 0.f; bool did_ = false; \
            while (mode_) { int nc_; thr_ = dsa_compact(mode_ == 2, scb + ql_ * DSA_CAP, ixb + ql_ * DSA_CAP, c_, lane, nc_); c_ = nc_; did_ = true; mode_ = (mode_ == 1 && c_ > 512) ? 2 : 0; } \
            if (did_) { if (ql_ == 0) cnt0 = c_; else if (ql_ == 1) cnt1 = c_; else if (ql_ == 2) cnt2 = c_; else cnt3 = c_; \
                if (g5 == (ql_ >> 1)) { if (ql_ & 1) tau1 = thr_; else tau0 = thr_; } } } } while (0)
#define DSA_SCORE(B, kb_) do { \
            f32x16 acc0_, acc1_; \
            _Pragma("unroll") for (int i_ = 0; i_ < 16; ++i_) { acc0_[i_] = 0.f; acc1_[i_] = 0.f; } \
            _Pragma("unroll") for (int ks_ = 0; ks_ < 4; ++ks_) { acc0_ = __builtin_amdgcn_mfma_f32_32x32x16_bf16(afr[ks_], B[0][ks_], acc0_, 0, 0, 0); \
                acc1_ = __builtin_amdgcn_mfma_f32_32x32x16_bf16(afr[ks_], B[1][ks_], acc1_, 0, 0, 0); } \
            _Pragma("unroll") for (int cb_ = 0; cb_ < 2; ++cb_) { \
                float s0 = 0.f, s1 = 0.f; \
                _Pragma("unroll") for (int i_ = 0; i_ < 8; ++i_) { const float r0_ = __builtin_amdgcn_fmed3f(cb_ ? acc1_[i_] : acc0_[i_], 0.f, INFINITY), r1_ = __builtin_amdgcn_fmed3f(cb_ ? acc1_[8 + i_] : acc0_[8 + i_], 0.f, INFINITY); \
                    s0 = __builtin_fmaf(wgt[i_], r0_, s0); s1 = __builtin_fmaf(wgt[8 + i_], r1_, s1); } \
                const unsigned key_ = (unsigned)((kb_) * 64 + cb_ * 32 + n32); \
                const bool p0_ = s0 > tau0, p1_ = s1 > tau1; \
                const unsigned long long m0 = __ballot(p0_), m1 = __ballot(p1_); \
                const unsigned m0h = g5 ? (unsigned)(m0 >> 32) : (unsigned)m0, m1h = g5 ? (unsigned)(m1 >> 32) : (unsigned)m1; \
                const unsigned below = (1u << n32) - 1u; \
                if (p0_) { const int pos = (2 * g5) * DSA_CAP + (g5 ? cnt2 : cnt0) + __builtin_popcount(m0h & below); scb[pos] = s0; ixb[pos] = (unsigned short)key_; } \
                if (p1_) { const int pos = (2 * g5 + 1) * DSA_CAP + (g5 ? cnt3 : cnt1) + __builtin_popcount(m1h & below); scb[pos] = s1; ixb[pos] = (unsigned short)key_; } \
                cnt0 += __builtin_popcount((unsigned)m0); cnt2 += __builtin_popcount((unsigned)(m0 >> 32)); \
                cnt1 += __builtin_popcount((unsigned)m1); cnt3 += __builtin_popcount((unsigned)(m1 >> 32)); } } while (0)
        bf16x8 bA[2][4], bB[2][4];
        DSA_LOADB(bA, 0);
        int kb = 0;
        while (kb < nkb) {
            if (cnt0 > 512 || cnt1 > 512 || cnt2 > 512 || cnt3 > 512) DSA_COMPACT_ALL(false, false);
            const int rem = nkb - kb;
            if (rem == 1) { DSA_SCORE(bA, kb); kb += 1; break; }
            const int mx = max(max(cnt0, cnt1), max(cnt2, cnt3));
            int np = (DSA_CAP - mx) >> 7; np = min(np, rem >> 1);
            for (int i = 0; i < np; ++i, kb += 2) {
                DSA_LOADB(bB, kb + 1);
                DSA_SCORE(bA, kb);
                DSA_LOADB(bA, min(kb + 2, nkb - 1));
                DSA_SCORE(bB, kb + 1);
            }
        }
        DSA_COMPACT_ALL(true, false);
#undef DSA_LOADB
#undef DSA_SCORE
#undef DSA_COMPACT_ALL
        const int col = lane & 15, kq = lane >> 4;
        for (int ql = 0; ql < 4; ++ql) {
            const int t = tq0 + ql; const int nsel = (ql == 0) ? cnt0 : (ql == 1) ? cnt1 : (ql == 2) ? cnt2 : cnt3;
            const LAS unsigned short* ixl = ixb + ql * DSA_CAP;
            const int nch = nsel >> 5;
            u32x4 gr[8];
#define DSA_GATHER(c, g_, off_) do { _Pragma("unroll") for (int i = 0; i < 8; ++i) { const unsigned kidx = ixl[(c) * 32 + kq + 4 * i]; \
                gr[i] = *(const u32x4*)(KV2 + ((size_t)kidx * 2 + (g_)) * 256 + (off_) + 8 * col); } } while (0)
#define DSA_PUT() do { _Pragma("unroll") for (int i = 0; i < 8; ++i) *(LAS u32x4*)(vst + (kq + 4 * i) * 272 + col * 16) = gr[i]; } while (0)
            for (int g = 0; g < 2; ++g) {
                bf16x8 qf[4];
#pragma unroll
                for (int ks = 0; ks < 4; ++ks) { if (col < 4) qf[ks] = *(const bf16x8*)(U + (size_t)t * PWP + UQ + 128 * (4 * g + col) + 32 * ks + 8 * kq); else qf[ks] = (bf16x8){0, 0, 0, 0, 0, 0, 0, 0}; }
                DSA_GATHER(0, g, 0);
                for (int c = 0; c < nch; ++c) {
                    DSA_PUT();
                    if (c + 1 < nch) DSA_GATHER(c + 1, g, 0); else DSA_GATHER(0, g, 128);
#pragma unroll
                    for (int kb2 = 0; kb2 < 2; ++kb2) {
                        f32x4 a4 = {0.f, 0.f, 0.f, 0.f};
#pragma unroll
                        for (int ks = 0; ks < 4; ++ks) { const bf16x8 kf = *(const LAS bf16x8*)(vst + (16 * kb2 + col) * 272 + (32 * ks + 8 * kq) * 2); a4 = __builtin_amdgcn_mfma_f32_16x16x32_bf16(kf, qf[ks], a4, 0, 0, 0); }
                        if (col < 4) {
#pragma unroll
                            for (int i = 0; i < 4; ++i) Pw[(32 * c + 16 * kb2 + 4 * kq + i) * 4 + col] = a4[i] * 0.08838834764831845f;
                        }
                    }
                }
                f32x4 sv[4]; f32x4 mx = {-INFINITY, -INFINITY, -INFINITY, -INFINITY};
#pragma unroll
                for (int jj = 0; jj < 4; ++jj) { if (lane + 64 * jj < nsel) sv[jj] = *(const LAS f32x4*)(Pw + (lane + 64 * jj) * 4); else sv[jj] = (f32x4){-INFINITY, -INFINITY, -INFINITY, -INFINITY};
#pragma unroll
                    for (int hh = 0; hh < 4; ++hh) mx[hh] = fmaxf(mx[hh], sv[jj][hh]); }
                f32x4 sm = {0.f, 0.f, 0.f, 0.f};
#pragma unroll
                for (int hh = 0; hh < 4; ++hh) { mx[hh] = wave_max(mx[hh]);
#pragma unroll
                    for (int jj = 0; jj < 4; ++jj) { sv[jj][hh] = __expf(sv[jj][hh] - mx[hh]); sm[hh] += sv[jj][hh]; }
                    sm[hh] = 1.f / wave_sum(sm[hh]); }
#pragma unroll
                for (int jj = 0; jj < 4; ++jj)
#pragma unroll
                    for (int hh = 0; hh < 4; ++hh) Pb[hh * 256 + lane + 64 * jj] = (unsigned short)f2bf(sv[jj][hh] * sm[hh]);
                f32x4 oacc[8];
#pragma unroll
                for (int db = 0; db < 8; ++db) oacc[db] = (f32x4){0.f, 0.f, 0.f, 0.f};
                const int tq = col >> 2, tp = col & 3;
                for (int c = 0; c < nch; ++c) {
                    DSA_PUT();
                    if (c + 1 < nch) DSA_GATHER(c + 1, g, 128);
                    bf16x8 pf = (bf16x8){0, 0, 0, 0, 0, 0, 0, 0};
                    if (col < 4) pf = *(const LAS bf16x8*)(Pb + col * 256 + 32 * c + 8 * kq);
                    const LAS unsigned char* vrow = vst + (8 * kq + tq) * 272 + 8 * tp;
#pragma unroll
                    for (int db = 0; db < 8; ++db) {
                        const v4i16_t lo = __builtin_amdgcn_ds_read_tr16_b64_v4i16((LAS v4i16_t*)(vrow + 32 * db));
                        const v4i16_t hi = __builtin_amdgcn_ds_read_tr16_b64_v4i16((LAS v4i16_t*)(vrow + 4 * 272 + 32 * db));
                        const bf16x8 vf = {lo[0], lo[1], lo[2], lo[3], hi[0], hi[1], hi[2], hi[3]};
                        oacc[db] = __builtin_amdgcn_mfma_f32_16x16x32_bf16(vf, pf, oacc[db], 0, 0, 0);
                    }
                }
                if (col < 4) {
#pragma unroll
                    for (int db = 0; db < 8; ++db) { u32x2 o; o.x = pk2(oacc[db][0], oacc[db][1]); o.y = pk2(oacc[db][2], oacc[db][3]);
                        *(u32x2*)(MIX + (size_t)t * DM + 128 * (4 * g + col) + 16 * db + 4 * kq) = o; }
                }
            }
#undef DSA_GATHER
#undef DSA_PUT
        }
    }
}

__device__ __forceinline__ void post_phase(Frame& F, const Args& a) {
    const bf16_t* U = (const bf16_t*)(F.ws + WS_U);
    bf16_t* MIX = (bf16_t*)(F.ws + WS_XN);
    const bf16_t* Vb = (const bf16_t*)(F.ws + WS_V); const float* BON = (const float*)(F.ws + WS_BON);
    const float *mu_g = a.in[13], *g2 = a.in[18], *gng = a.in[22], *gnb = a.in[23];
    LAS float* xg = (LAS float*)F.lds;
    constexpr int TT = 16;
    const int c0 = 2 * F.tid;
    const bool upper = (F.lane & 32) != 0; const int hd = 2 * F.wave + (upper ? 1 : 0);
    const f32x2 ggv = *(const f32x2*)(gng + c0), gbv = *(const f32x2*)(gnb + c0);
    for (int tile = F.bid; tile < S / TT; tile += F.G) {
        const int t0 = tile * TT;
        __syncthreads();
        for (int e = F.tid; e < TT * 64; e += NTHR) {
            const int tt = e >> 6, d = e & 63, t = t0 + tt;
            const float cur = bf2f(U[(size_t)t * PWP + UGD + d]); const float prv = t > 0 ? bf2f(U[(size_t)(t - 1) * PWP + UGD + d]) : 0.f;
            xg[tt * 64 + d] = sigmoidf_(cur + (prv - cur) * mu_g[d]);
        }
        __syncthreads();
        f32x2 gg[TT];
#pragma unroll
        for (int tt = 0; tt < TT; ++tt) gg[tt] = (f32x2){0.f, 0.f};
        for (int d = 0; d < 64; d += 4) {
            f32x2 wv[4];
#pragma unroll
            for (int q = 0; q < 4; ++q) wv[q] = *(const f32x2*)(g2 + (d + q) * 1024 + c0);
#pragma unroll
            for (int tt = 0; tt < TT; ++tt) { const f32x4 xv = *(const LAS f32x4*)(xg + tt * 64 + d);
#pragma unroll
                for (int q = 0; q < 4; ++q) gg[tt] += wv[q] * xv[q]; }
        }
        LAS float* gl = xg + 16 * 64;
#pragma unroll
        for (int tt = 0; tt < TT; ++tt) *(LAS f32x2*)(gl + tt * 1024 + c0) = gg[tt];
#pragma unroll 4
        for (int tt = 0; tt < TT; ++tt) {
            const int t = t0 + tt; const float* yrow = (const float*)((const unsigned char*)U + (size_t)t * (PWP * 2) + URR * 2);
            const f32x2 y = *(const f32x2*)(yrow + c0);
            const unsigned vq = *(const unsigned*)(Vb + (size_t)t * 1024 + c0);
            const float mean = half_sum(y.x + y.y, upper) * (1.f / 64.f); const f32x2 dlt = y - mean;
            const float var = half_sum(dlt.x * dlt.x + dlt.y * dlt.y, upper) * (1.f / 64.f);
            f32x2 o = dlt * (1.f / sqrtf(var + GN_EPS)) * ggv + gbv;
            o += (f32x2){bflo(vq), bfhi(vq)} * BON[t * 16 + hd];
            o = o * *(const LAS f32x2*)(gl + tt * 1024 + c0);
            *(unsigned*)(MIX + (size_t)t * DM + 1024 + c0) = pk2(o.x, o.y);
        }
    }
}

__device__ __forceinline__ void light_grid_barrier(unsigned* ctr, unsigned target) {
    __syncthreads();
    if (threadIdx.x == 0) {
        __threadfence();
        __hip_atomic_fetch_add(ctr, 1u, __ATOMIC_RELAXED, __HIP_MEMORY_SCOPE_AGENT);
        while (__hip_atomic_load(ctr, __ATOMIC_RELAXED, __HIP_MEMORY_SCOPE_AGENT) < target) __builtin_amdgcn_s_sleep(2);
        __threadfence();
    }
    __syncthreads();
}
constexpr int NPHASE = 13;
__global__ void __launch_bounds__(NTHR, 2) fwd_kernel(Args a) {
    extern __shared__ __attribute__((aligned(16))) unsigned char lds_raw[];
    Frame F; F.lds = (LAS unsigned char*)lds_raw; F.tid = threadIdx.x; F.lane = F.tid & 63; F.wave = __builtin_amdgcn_readfirstlane(F.tid >> 6); F.G = gridDim.x; F.bid = blockIdx.x; F.ws = a.ws;
    cg::grid_group grid = cg::this_grid();
    volatile LAS unsigned* xst = (volatile LAS unsigned*)(F.lds + LDS_BYTES - 64);
    if (F.tid < 4) xst[F.tid] = 0u;
    __syncthreads();
    const XcdBarrier xbar = xcd_barrier_post((unsigned*)(F.ws + WS_CTL + 4096), xst, (unsigned)F.G, true);
    const bool is_scan = (F.bid & 7) < 2;
    const int scan_idx = (F.bid >> 3) * 2 + (F.bid & 7), sh_idx = (F.bid >> 3) * 6 + ((F.bid & 7) - 2);
    const XcdBarrier xbar2 = xcd_barrier_post((unsigned*)(F.ws + WS_CTL + 20480), xst + 2, (unsigned)(F.G - 64), !is_scan);
    const int lo = a.ph_lo, hi = a.ph_hi;
#define IN(k) (lo <= (k) && (k) < hi)
    unsigned nbar = 0; unsigned* barw = (unsigned*)(F.ws + WS_CTL + 256);
    if (lo < 0) grid.sync();
#define SEAM(k) do { if (IN(k) && IN((k) + 1)) xcd_barrier(xbar); } while (0)
    bf16_t* ACT = (bf16_t*)(F.ws + WS_U); bf16_t* XN = (bf16_t*)(F.ws + WS_XN);
    bf16_t* WGU = (bf16_t*)(F.ws + WS_WB); bf16_t* WDN = (bf16_t*)(F.ws + WS_WB2); bf16_t* WOUT = (bf16_t*)(F.ws + WS_WOUT);
    if (IN(0)) {
        if (F.bid == 0 && F.tid == 0) *(unsigned*)(F.ws + WS_CTL) = 0u;
        convert_weight<1>(F, a.in[2], a.in[3], DM, FF, 2 * FF, WGU);
        convert_weight<0>(F, a.in[4], nullptr, FF, DM, DM, WDN);
        rmsnorm_rows<true>(F, a.in[0], a.in[1], XN);
    }
    SEAM(0);
    if (IN(1)) { pg8::Gemm g{XN, WGU, S, 2 * FF, DM}; pg8::StaticOrder So; So.init(S, 2 * FF, F.G, F.bid); pg8::EpiSwiglu E{ACT, FF}; pg8::gemm_phase(F.lds, g, So, E); }
#if defined(PROBE_REPG)
    grid.sync();
    if (IN(1)) { pg8::Gemm g{XN, WGU, S, 2 * FF, DM}; pg8::StaticOrder So; So.init(S, 2 * FF, F.G, F.bid); pg8::EpiSwiglu E{ACT, FF}; pg8::gemm_phase(F.lds, g, So, E); }
#endif
    SEAM(1);
    if (IN(2)) { pg8::Gemm g{ACT, WDN, S, DM, FF}; pg8::StaticOrder So; So.init(S, DM, F.G, F.bid); pg8::EpiResF32 E{a.in[0], a.out, DM, 0.5f}; pg8::gemm_phase(F.lds, g, So, E); }
    SEAM(2);
    if (IN(3)) {
        convert_weight<2>(F, a.in[6], nullptr, DM, PW, NG1, (bf16_t*)(F.ws + WS_KV2));
        convert_weight<3>(F, a.in[6], nullptr, DM, PW, NG2, (bf16_t*)(F.ws + WS_WIN2));
        convert_weight<0>(F, a.in[7], nullptr, DM, DM, DM, WOUT);
        rmsnorm_rows<true>(F, a.out, a.in[5], XN);
    }
#if defined(PROBE_REPC)
    grid.sync();
    if (IN(3)) {
        convert_weight<2>(F, a.in[6], nullptr, DM, PW, NG1, (bf16_t*)(F.ws + WS_KV2));
        convert_weight<3>(F, a.in[6], nullptr, DM, PW, NG2, (bf16_t*)(F.ws + WS_WIN2));
        convert_weight<0>(F, a.in[7], nullptr, DM, DM, DM, WOUT);
        rmsnorm_rows<true>(F, a.out, a.in[5], XN);
    }
#endif
    SEAM(3);
    constexpr int M1 = 16 * 256, T1 = M1 / 16;
    constexpr int NG1A = 3072;
    if (IN(4)) {
        const bf16_t* WIN1 = (const bf16_t*)(F.ws + WS_KV2);
        if (F.bid < 192) { pg8::Gemm g{XN, WIN1, M1, NG1A, DM}; pg8::StaticOrder So; So.init(M1, NG1A, 192, F.bid); pg8::EpiBf16 E{ACT, PWP}; pg8::gemm_phase(F.lds, g, So, E); }
        else { pg8::Gemm g{XN, WIN1 + (size_t)NG1A * DM, S, 256, DM}; pg8::StaticOrder So; So.init(S, 256, F.G - 192, F.bid - 192); pg8::EpiBf16 E{ACT + NG1A, PWP}; pg8::gemm_phase(F.lds, g, So, E); }
    }
    SEAM(4);
    if (IN(5)) prep_rwkv(F, a, 0, T1, F.bid, F.G);
    SEAM(5);
    if (IN(6)) {
        unsigned* shw = (unsigned*)(F.ws + WS_CTL + 20480); const int nsh = F.G - 64;
        if (is_scan) { rwkv_scan(F, scan_idx, shw, 2u, (M1 / RW_TB - 4) & ~1); xcd_wait(shw, 4u); }
        else {
            { pg8::Gemm g{XN + (size_t)M1 * DM, (const bf16_t*)(F.ws + WS_KV2), S - M1, NG1A, DM}; pg8::StaticOrder So; So.init(S - M1, NG1A, nsh, sh_idx); pg8::EpiBf16 E{ACT + (size_t)M1 * PWP, PWP}; pg8::gemm_phase(F.lds, g, So, E); }
            xcd_barrier(xbar2);
            prep_rwkv(F, a, T1, S / 16, sh_idx, nsh);
            xcd_barrier(xbar2);
            { pg8::Gemm g{XN, (const bf16_t*)(F.ws + WS_WIN2), S, NG2, DM}; pg8::StaticOrder So; So.init(S, NG2, nsh, sh_idx); pg8::EpiBf16 E{ACT + NG1, PWP}; pg8::gemm_phase(F.lds, g, So, E); }
            xcd_barrier(xbar2);
            prep_rope(F, a, sh_idx, nsh);
            xcd_barrier(xbar2);
        }
        dsa_phase(F);
    }
#if defined(PROBE_REP6)
    grid.sync(); if (F.bid == 0 && F.tid == 0) *(unsigned*)(F.ws + WS_CTL) = 0u; grid.sync();
#if PROBE_REP6 == 1
    if (IN(6)) { if (F.bid < 64) rwkv_scan(F, F.bid); dsa_phase(F); }
#elif PROBE_REP6 == 2
    if (IN(6)) { if (F.bid < 64) rwkv_scan(F, F.bid); }
#elif PROBE_REP6 == 3
    if (IN(6)) { dsa_phase(F); }
#else
    if (IN(6)) { dsa_phase(F); }
#endif
#endif
    SEAM(6);
    if (IN(7)) post_phase(F, a);
    SEAM(7);
    if (IN(8)) { pg8::Gemm g{XN, WOUT, S, DM, DM}; pg8::StaticOrder So; So.init(S, DM, F.G, F.bid); pg8::EpiResF32 E{a.out, a.out, DM, 1.0f}; pg8::gemm_phase(F.lds, g, So, E); }
    SEAM(8);
    if (IN(9)) {
        convert_weight<1>(F, a.in[25], a.in[26], DM, FF, 2 * FF, WGU);
        convert_weight<0>(F, a.in[27], nullptr, FF, DM, DM, WDN);
        rmsnorm_rows<true>(F, a.out, a.in[24], XN);
    }
    SEAM(9);
    if (IN(10)) { pg8::Gemm g{XN, WGU, S, 2 * FF, DM}; pg8::StaticOrder So; So.init(S, 2 * FF, F.G, F.bid); pg8::EpiSwiglu E{ACT, FF}; pg8::gemm_phase(F.lds, g, So, E); }
    SEAM(10);
    if (IN(11)) { pg8::Gemm g{ACT, WDN, S, DM, FF}; pg8::StaticOrder So; So.init(S, DM, F.G, F.bid); pg8::EpiResF32 E{a.out, a.out, DM, 0.5f}; pg8::gemm_phase(F.lds, g, So, E); }
    SEAM(11);
    if (IN(12)) rmsnorm_rows<false>(F, a.out, a.in[28], a.out);
#undef IN
#undef SEAM
}


#ifndef MK_MULTI
#define MK_MULTI 0
#endif
extern "C" void kernel_launch(void* const* d_in, const int* in_sizes, int n_in, void* d_out, int out_size, void* d_ws, size_t ws_size, hipStream_t stream) {
    static int grid = 0;
    if (grid == 0) {
        if (n_in != 29 || out_size != S * DM || ws_size < WS_END) { fprintf(stderr, "kernel_launch: unexpected shapes n_in %d out %d ws %zu\n", n_in, out_size, ws_size); grid = -1; return; }
        int dev = 0, cus = 0, per_cu = 0;
        (void)hipGetDevice(&dev); (void)hipDeviceGetAttribute(&cus, hipDeviceAttributeMultiprocessorCount, dev);
        if (hipFuncSetAttribute((const void*)fwd_kernel, hipFuncAttributeMaxDynamicSharedMemorySize, LDS_BYTES) != hipSuccess) { fprintf(stderr, "kernel_launch: hipFuncSetAttribute failed\n"); grid = -1; return; }
        (void)hipOccupancyMaxActiveBlocksPerMultiprocessor(&per_cu, (const void*)fwd_kernel, NTHR, LDS_BYTES);
        if (per_cu < 1) per_cu = 1;
        (void)hipGetLastError();
        grid = cus * per_cu;
        fprintf(stderr, "kernel_launch: grid %d (cus %d per_cu %d)\n", grid, cus, per_cu);
    }
    if (grid < 0) return;
    (void)hipMemsetAsync((char*)d_ws + WS_CTL, 0, 65536, stream);
    Args a{};
    for (int i = 0; i < 29; ++i) a.in[i] = (const float*)d_in[i];
    a.out = (float*)d_out; a.ws = (unsigned char*)d_ws;
    for (int i = 0; i < 16; ++i) a.inv32[i] = powf(500000.0f, -((float)i * 2.0f / 32.0f));
    for (int i = 0; i < 8; ++i) a.inv16[i] = powf(500000.0f, -((float)i * 2.0f / 16.0f));
#if MK_MULTI
    for (int p = 0; p < NPHASE; ++p) { a.ph_lo = p; a.ph_hi = p + 1; hipLaunchKernelGGL(fwd_kernel, dim3(grid), dim3(NTHR), LDS_BYTES, stream, a); }
#else
    a.ph_lo = 0; a.ph_hi = NPHASE;
    void* args[] = {&a};
    hipError_t e = hipLaunchCooperativeKernel((const void*)fwd_kernel, dim3(grid), dim3(NTHR), args, LDS_BYTES, stream);
    if (e != hipSuccess) fprintf(stderr, "cooperative launch failed: %s (grid %d)\n", hipGetErrorString(e), grid);
#endif
}
```

```cpp
#include <hip/hip_runtime.h>
#include <hip/hip_cooperative_groups.h>
#include <cstdio>
#include <cstdint>
#include <cmath>
namespace cg = cooperative_groups;

#define LAS __attribute__((address_space(3)))
typedef unsigned short bf16_t;
typedef short bf16x8 __attribute__((ext_vector_type(8)));
typedef float f32x4 __attribute__((ext_vector_type(4)));
typedef float f32x2 __attribute__((ext_vector_type(2)));
typedef float f32x16 __attribute__((ext_vector_type(16)));
typedef unsigned u32x4 __attribute__((ext_vector_type(4)));
typedef unsigned u32x2 __attribute__((ext_vector_type(2)));

constexpr int S = 16384, DM = 2048, FF = 5632, PW = 5384, PWP = 5632;
constexpr int NTHR = 512, NWAVES = 8;
constexpr int URR = 0, URK = 1024, URV = 2048, UWD = 3072, UAD = 3136, UGD = 3200, NG1 = 3328, UQ = 3328, UK = 4352, UV = 4608, UQI = 4864, UKI = 5376, UWI = 5440, NG2 = 2304;
static_assert(NG1 + NG2 == 5632, "in-proj column groups");
constexpr float NORM_EPS = 1e-6f, GN_EPS = 64e-5f;
constexpr size_t MiB = 1u << 20;
constexpr size_t WS_U = 0;
constexpr size_t WS_XN = 176 * MiB;
constexpr size_t WS_WB = 240 * MiB;
constexpr size_t WS_WB2 = 284 * MiB;
constexpr size_t WS_R = 240 * MiB, WS_V = 272 * MiB;
constexpr size_t WS_W = 306 * MiB;
constexpr size_t WS_A = 370 * MiB, WS_B = 402 * MiB, WS_KP = 434 * MiB;
constexpr size_t WS_WOUT = 466 * MiB;
constexpr size_t WS_BR = 474 * MiB, WS_KR = 475 * MiB, WS_BON = 476 * MiB;
constexpr size_t WS_CTL = 477 * MiB;
constexpr size_t WS_KI2 = 478 * MiB;
constexpr size_t WS_KV2 = 480 * MiB;
constexpr size_t WS_WIN2 = 496 * MiB;
constexpr size_t WS_END = 506 * MiB;
constexpr int LDS_BYTES = 163840;

__device__ __forceinline__ unsigned f2bf(float f) { unsigned u = __builtin_bit_cast(unsigned, f); return (u + 0x7fffu + ((u >> 16) & 1u)) >> 16; }
__device__ __forceinline__ unsigned pk2(float lo, float hi) { return f2bf(lo) | (f2bf(hi) << 16); }
__device__ __forceinline__ float bf2f(unsigned b) { return __builtin_bit_cast(float, b << 16); }
__device__ __forceinline__ float bflo(unsigned p) { return __builtin_bit_cast(float, p << 16); }
__device__ __forceinline__ float bfhi(unsigned p) { return __builtin_bit_cast(float, p & 0xffff0000u); }
template <int CTRL> __device__ __forceinline__ float dppf(float v) {
    return __builtin_bit_cast(float, __builtin_amdgcn_update_dpp(0, __builtin_bit_cast(int, v), CTRL, 0xF, 0xF, false));
}
__device__ __forceinline__ float red16(float v) {
    v += dppf<0xB1>(v); v += dppf<0x4E>(v); v += dppf<0x141>(v); v += dppf<0x140>(v); return v;
}

template <int CTRL, int ROWMASK> __device__ __forceinline__ float dppf_m(float oldv, float v) {
    return __builtin_bit_cast(float, __builtin_amdgcn_update_dpp(__builtin_bit_cast(int, oldv), __builtin_bit_cast(int, v), CTRL, ROWMASK, 0xF, false));
}
__device__ __forceinline__ float wave_sum(float v) {
    v += dppf<0xB1>(v); v += dppf<0x4E>(v); v += dppf<0x141>(v); v += dppf<0x140>(v);
    v += dppf_m<0x142, 0xA>(0.f, v);
    v += dppf_m<0x143, 0xC>(0.f, v);
    return __builtin_bit_cast(float, __builtin_amdgcn_readlane(__builtin_bit_cast(int, v), 63));
}
__device__ __forceinline__ float wave_max(float v) {
    v = fmaxf(v, dppf<0xB1>(v)); v = fmaxf(v, dppf<0x4E>(v)); v = fmaxf(v, dppf<0x141>(v)); v = fmaxf(v, dppf<0x140>(v));
    v = fmaxf(v, dppf_m<0x142, 0xA>(v, v));
    v = fmaxf(v, dppf_m<0x143, 0xC>(v, v));
    return __builtin_bit_cast(float, __builtin_amdgcn_readlane(__builtin_bit_cast(int, v), 63));
}
namespace pg8 {
constexpr int BM = 256, BK = 64, HALF = 128, HTB = HALF * BK * 2, STAGE_BYTES = 8 * HTB, NXCD = 8, WGM = 4;
__host__ __device__ __forceinline__ int lds_byte(int r, int c) { const int st = (r >> 4) * 2 + (c >> 5), rr = r & 15, cc = c & 31, ob = rr * 64 + cc * 2; return st * 1024 + (ob ^ (((ob >> 9) & 1) << 5)); }
__host__ __device__ __forceinline__ void stage_rc(int b, int& R, int& C) { const int st = b / 1024, sb = b % 1024, swz = sb ^ (((sb >> 9) & 1) << 5); R = (st >> 1) * 16 + swz / 64; C = (st & 1) * 32 + (swz % 64) / 2; }
__host__ __device__ __forceinline__ int perm32(int rho) { const int n = rho >> 4, i = rho & 15; return 8 * (i >> 2) + 4 * n + (i & 3); }
struct Unit { int pm, pn; };
struct Gemm { const bf16_t* A; const bf16_t* Bt; int M, N, K; };
struct StaticOrder {
    int nM, nN, nwg, G, c;
    __host__ __device__ void init(int M, int N, int G_, int c_) { nM = M / BM; nN = N / BM; nwg = nM * nN; G = G_; c = c_; }
    __host__ __device__ bool next(int i, Unit& u) const {
        const long L = (long)i * G + c; if (L >= nwg) return false;
        int wgid = (int)L; { const int q = nwg / NXCD, r = nwg % NXCD, xcd = wgid % NXCD, off = wgid / NXCD; wgid = (xcd < r ? xcd * (q + 1) : r * (q + 1) + (xcd - r) * q) + off; }
        const int nig = WGM * nN, gid = wgid / nig, fm = gid * WGM, gsz = (nM - fm) < WGM ? (nM - fm) : WGM;
        u.pm = fm + ((wgid % nig) % gsz); u.pn = (wgid % nig) / gsz; return true;
    }
};
__device__ __forceinline__ unsigned cvt_pk_bf16(float lo, float hi) { unsigned r; asm volatile("v_cvt_pk_bf16_f32 %0, %1, %2" : "=v"(r) : "v"(lo), "v"(hi)); return r; }

struct EpiBf16 {
    bf16_t* O; int ldc;
    __device__ __forceinline__ void operator()(const f32x4 (&acc)[2][2][4][2], const Unit& u, int wr, int wc, int fr, int fq) const {
        const int row0 = u.pm * BM + wr * 64 + fr, col0 = u.pn * BM + wc * 32 + 8 * fq;
#pragma unroll
        for (int ai = 0; ai < 2; ++ai)
#pragma unroll
            for (int m = 0; m < 4; ++m) { bf16_t* rowp = O + (size_t)(row0 + ai * HALF + m * 16) * ldc + col0;
#pragma unroll
                for (int bj = 0; bj < 2; ++bj) { const f32x4 v0 = acc[ai][bj][m][0], v1 = acc[ai][bj][m][1];
                    u32x4 w; w.x = cvt_pk_bf16(v0[0], v0[1]); w.y = cvt_pk_bf16(v0[2], v0[3]); w.z = cvt_pk_bf16(v1[0], v1[1]); w.w = cvt_pk_bf16(v1[2], v1[3]);
                    *(u32x4*)(rowp + bj * HALF) = w; } }
    }
};
struct EpiSwiglu {
    bf16_t* O; int ldc;
    __device__ __forceinline__ void operator()(const f32x4 (&acc)[2][2][4][2], const Unit& u, int wr, int wc, int fr, int fq) const {
        const int row0 = u.pm * BM + wr * 64 + fr, col0 = (u.pn * BM + wc * 32) / 2 + 4 * fq;
#pragma unroll
        for (int ai = 0; ai < 2; ++ai)
#pragma unroll
            for (int m = 0; m < 4; ++m) { bf16_t* rowp = O + (size_t)(row0 + ai * HALF + m * 16) * ldc + col0;
#pragma unroll
                for (int bj = 0; bj < 2; ++bj) { const f32x4 g = acc[ai][bj][m][0], up = acc[ai][bj][m][1];
                    float a[4];
#pragma unroll
                    for (int e = 0; e < 4; ++e) a[e] = g[e] * __builtin_amdgcn_rcpf(1.f + __expf(-g[e])) * up[e];
                    u32x2 w; w.x = cvt_pk_bf16(a[0], a[1]); w.y = cvt_pk_bf16(a[2], a[3]);
                    *(u32x2*)(rowp + bj * (HALF / 2)) = w; } }
    }
};
struct EpiResF32 {
    const float* base; float* out; int ldc; float scale;
    __device__ __forceinline__ void operator()(const f32x4 (&acc)[2][2][4][2], const Unit& u, int wr, int wc, int fr, int fq) const {
        const int row0 = u.pm * BM + wr * 64 + fr, col0 = u.pn * BM + wc * 32 + 8 * fq;
#pragma unroll
        for (int ai = 0; ai < 2; ++ai)
#pragma unroll
            for (int m = 0; m < 4; ++m) { const size_t ro = (size_t)(row0 + ai * HALF + m * 16) * ldc + col0;
#pragma unroll
                for (int bj = 0; bj < 2; ++bj) {
                    const f32x4 b0 = *(const f32x4*)(base + ro + bj * HALF), b1 = *(const f32x4*)(base + ro + bj * HALF + 4);
                    *(f32x4*)(out + ro + bj * HALF) = b0 + acc[ai][bj][m][0] * scale;
                    *(f32x4*)(out + ro + bj * HALF + 4) = b1 + acc[ai][bj][m][1] * scale; } }
    }
};

template <class Epi, class Sched>
__device__ __forceinline__ void gemm_phase(LAS unsigned char* lds, const Gemm g, const Sched& S, const Epi& E) {
    const int tid = threadIdx.x, wid = __builtin_amdgcn_readfirstlane(tid >> 6), lane = tid & 63, wr = wid >> 2, wc = wid & 3, fr = lane & 15, fq = lane >> 4;
    const int K = g.K, nt = K / BK;
    unsigned voffA[2], voffB[2];
#pragma unroll
    for (int i = 0; i < 2; ++i) { int R, C; stage_rc(tid * 16 + i * 8192, R, C); const int Rb = (R & ~31) + perm32(R & 31);
        voffA[i] = (unsigned)(R * K + C) * 2u; voffB[i] = (unsigned)(Rb * K + C) * 2u; }
    const size_t kstep = (size_t)(BK * 2);
    const size_t hstep = (size_t)HALF * K * 2;
    const size_t tstep = 2 * hstep;
    const unsigned ldsw = (unsigned)wid * 1024u;
    const int aoff = lds_byte(wr * 64 + fr, fq * 8), boff = lds_byte(wc * 32 + fr, fq * 8);
#define PG8_SA(b, h) (((b) * 2 + (h)) * HTB)
#define PG8_SB(b, h) ((4 + (b) * 2 + (h)) * HTB)
#define PG8_STAGE(bufoff, gbase, voff) do { _Pragma("unroll") for (int _i = 0; _i < 2; ++_i) \
        __builtin_amdgcn_global_load_lds((const unsigned*)((const char*)(gbase) + (voff)[_i]), (LAS unsigned*)(lds + (bufoff) + ldsw + _i * 8192), 16, 0, 0); } while (0)
#define PG8_LDA(dst, b, h) do { _Pragma("unroll") for (int m = 0; m < 4; ++m) _Pragma("unroll") for (int k = 0; k < 2; ++k) dst[m][k] = *(const LAS bf16x8*)(lds + PG8_SA(b, h) + aoff + m * 2048 + k * 1024); } while (0)
#define PG8_LDB(dst, b, h) do { _Pragma("unroll") for (int n = 0; n < 2; ++n) _Pragma("unroll") for (int k = 0; k < 2; ++k) dst[n][k] = *(const LAS bf16x8*)(lds + PG8_SB(b, h) + boff + n * 2048 + k * 1024); } while (0)
#define PG8_MMA(ai, bj, At, Bt) do { __builtin_amdgcn_s_setprio(1); _Pragma("unroll") for (int m = 0; m < 4; ++m) _Pragma("unroll") for (int n = 0; n < 2; ++n) _Pragma("unroll") for (int k = 0; k < 2; ++k) \
        acc[ai][bj][m][n] = __builtin_amdgcn_mfma_f32_16x16x32_bf16(Bt[n][k], At[m][k], acc[ai][bj][m][n], 0, 0, 0); __builtin_amdgcn_s_setprio(0); } while (0)
#define PG8_WAIT_V(n) asm volatile("s_waitcnt vmcnt(" #n ")" ::: "memory")
#define PG8_WAIT_L(n) asm volatile("s_waitcnt lgkmcnt(" #n ")" ::: "memory")
#define PG8_BAR __builtin_amdgcn_s_barrier()
#define PG8_SCHED __builtin_amdgcn_sched_barrier(0)
    Unit cur, nxt; int ui = 0;
    if (!S.next(0, cur)) return;
    f32x4 acc[2][2][4][2];
#pragma unroll
    for (int a = 0; a < 2; ++a)
#pragma unroll
        for (int b = 0; b < 2; ++b)
#pragma unroll
            for (int m = 0; m < 4; ++m)
#pragma unroll
                for (int n = 0; n < 2; ++n) acc[a][b][m][n] = (f32x4){0.f, 0.f, 0.f, 0.f};
    bf16x8 At[4][2], B0[2][2], B1[2][2];
    const char* cA = (const char*)g.A + (size_t)cur.pm * tstep; const char* cB = (const char*)g.Bt + (size_t)cur.pn * tstep;
    PG8_STAGE(PG8_SB(0, 0), cB, voffB); PG8_STAGE(PG8_SB(0, 1), cB + hstep, voffB); PG8_STAGE(PG8_SA(0, 0), cA, voffA); PG8_STAGE(PG8_SA(0, 1), cA + hstep, voffA);
    if (wr == 1) PG8_BAR;
    PG8_WAIT_V(2); PG8_BAR;
    PG8_STAGE(PG8_SB(1, 0), cB + kstep, voffB); PG8_STAGE(PG8_SA(1, 0), cA + kstep, voffA); PG8_STAGE(PG8_SB(1, 1), cB + hstep + kstep, voffB);
    PG8_WAIT_V(6); PG8_BAR;
    for (;;) {
        const bool has_next = S.next(ui + 1, nxt);
        const char* nA = has_next ? (const char*)g.A + (size_t)nxt.pm * tstep : cA; const char* nB = has_next ? (const char*)g.Bt + (size_t)nxt.pn * tstep : cB;
        for (int t = 0; t < nt; t += 2) {
            const bool last = (t == nt - 2);
            const char* a1 = cA + (size_t)(t + 1) * kstep;
            const char* a2 = last ? nA : cA + (size_t)(t + 2) * kstep; const char* b2 = last ? nB : cB + (size_t)(t + 2) * kstep;
            const char* a3 = a2 + kstep; const char* b3 = b2 + kstep;
            PG8_LDB(B0, 0, 0); PG8_LDB(B1, 0, 1); PG8_SCHED; PG8_LDA(At, 0, 0); PG8_STAGE(PG8_SA(1, 1), a1 + hstep, voffA);
            PG8_WAIT_V(8); PG8_WAIT_L(0); PG8_BAR; PG8_MMA(0, 0, At, B0); PG8_MMA(0, 1, At, B1); PG8_BAR; PG8_SCHED;
            PG8_LDA(At, 0, 1); PG8_STAGE(PG8_SB(0, 0), b2, voffB); PG8_STAGE(PG8_SB(0, 1), b2 + hstep, voffB); PG8_STAGE(PG8_SA(0, 0), a2, voffA);
            PG8_WAIT_V(8); PG8_WAIT_L(0); PG8_BAR; PG8_MMA(1, 0, At, B0); PG8_MMA(1, 1, At, B1); PG8_BAR; PG8_SCHED;
            PG8_LDB(B0, 1, 0); PG8_LDB(B1, 1, 1); PG8_SCHED; PG8_LDA(At, 1, 0); PG8_STAGE(PG8_SA(0, 1), a2 + hstep, voffA);
            PG8_WAIT_V(8); PG8_WAIT_L(0); PG8_BAR; PG8_MMA(0, 0, At, B0); PG8_MMA(0, 1, At, B1); PG8_BAR; PG8_SCHED;
            PG8_LDA(At, 1, 1); PG8_STAGE(PG8_SB(1, 0), b3, voffB); PG8_STAGE(PG8_SB(1, 1), b3 + hstep, voffB); PG8_STAGE(PG8_SA(1, 0), a3, voffA);
            PG8_WAIT_V(8); PG8_WAIT_L(0); PG8_BAR; PG8_MMA(1, 0, At, B0); PG8_MMA(1, 1, At, B1); PG8_BAR; PG8_SCHED;
        }
        if (wr == 0) PG8_BAR;
        E(acc, cur, wr, wc, fr, fq);
        if (!has_next) break;
#pragma unroll
        for (int a = 0; a < 2; ++a)
#pragma unroll
            for (int b = 0; b < 2; ++b)
#pragma unroll
                for (int m = 0; m < 4; ++m)
#pragma unroll
                    for (int n = 0; n < 2; ++n) acc[a][b][m][n] = (f32x4){0.f, 0.f, 0.f, 0.f};
        cur = nxt; cA = nA; cB = nB; ++ui;
        if (wr == 1) PG8_BAR;
    }
    PG8_WAIT_V(0);
    PG8_BAR;
#undef PG8_SA
#undef PG8_SB
#undef PG8_STAGE
#undef PG8_LDA
#undef PG8_LDB
#undef PG8_MMA
#undef PG8_WAIT_V
#undef PG8_WAIT_L
#undef PG8_BAR
#undef PG8_SCHED
}
}

struct Args { const float* in[29]; float* out; unsigned char* ws; float inv32[16]; float inv16[8]; int ph_lo, ph_hi; };

struct Frame {
    LAS unsigned char* lds;
    int tid, lane, wave, G, bid;
    unsigned char* ws;
};

#define LDS_WAIT() asm volatile("s_waitcnt lgkmcnt(0)" ::: "memory")

template <int MODE>
__device__ __forceinline__ void transpose_item(const float* W, const float* W2, int K, int Nsrc, int Ndst, bf16_t* WT, LAS float* scr, int item, int lane) {
    const int nblk = Ndst / 64, kb = item / nblk, nb = item % nblk, k0 = 64 * kb, n0 = 64 * nb;
    const int c4 = lane & 15, r4 = lane >> 4;
    const float* src; bool ok = true; int lcol;
    if (MODE == 0) { src = W + n0 + 4 * c4; ok = (n0 + 4 * c4) < Nsrc; lcol = 4 * c4; }
    else if (MODE == 2) {
        const int n = n0 + 4 * c4; int sc = -1; if (n < 3264) sc = 2120 + n; else if (n >= 3328 && n < 3328 + 2120) sc = n - 3328;
        ok = sc >= 0; src = W + (ok ? sc : 0); lcol = 4 * c4; }
    else if (MODE == 3) { const int n = n0 + 4 * c4; ok = n < 2120; src = W + (ok ? n : 0); lcol = 4 * c4; }
    else { const int t = c4 >> 3, g = c4 & 7; src = (t ? W2 : W) + n0 / 2 + 4 * g; lcol = 8 * g + 4 * t; }
    f32x4 v[16];
#pragma unroll
    for (int i = 0; i < 16; ++i) v[i] = ok ? *(const f32x4*)(src + (size_t)(k0 + 4 * i + r4) * Nsrc) : (f32x4){0.f, 0.f, 0.f, 0.f};
#pragma unroll
    for (int i = 0; i < 16; ++i) { LAS float* d = scr + (4 * i + r4) * 65 + lcol; d[0] = v[i].x; d[1] = v[i].y; d[2] = v[i].z; d[3] = v[i].w; }
    LDS_WAIT(); asm volatile("" ::: "memory");
    const int c = lane & 7;
#pragma unroll
    for (int j = 0; j < 8; ++j) { const int n = (lane >> 3) + 8 * j; const LAS float* sp = scr + (8 * c) * 65 + n;
        u32x4 o; o.x = pk2(sp[0 * 65], sp[1 * 65]); o.y = pk2(sp[2 * 65], sp[3 * 65]); o.z = pk2(sp[4 * 65], sp[5 * 65]); o.w = pk2(sp[6 * 65], sp[7 * 65]);
        *(u32x4*)(WT + (size_t)(n0 + n) * K + k0 + 8 * c) = o; }
    LDS_WAIT(); asm volatile("" ::: "memory");
}
template <int MODE>
__device__ __forceinline__ void convert_weight(Frame& F, const float* W, const float* W2, int K, int Nsrc, int Ndst, bf16_t* WT) {
    LAS float* scr = (LAS float*)(F.lds + F.wave * 17408);
    const int gw = F.bid * NWAVES + F.wave, NGW = F.G * NWAVES, nitems = (K / 64) * (Ndst / 64);
    for (int it = gw; it < nitems; it += NGW) transpose_item<MODE>(W, W2, K, Nsrc, Ndst, WT, scr, it, F.lane);
}
template <bool OUT_BF16>
__device__ __forceinline__ void rmsnorm_rows(Frame& F, const float* X, const float* gain, void* O) {
    const int gw = F.bid * NWAVES + F.wave, NGW = F.G * NWAVES;
    f32x4 gv[8];
#pragma unroll
    for (int j = 0; j < 8; ++j) gv[j] = ((const f32x4*)gain)[F.lane + 64 * j];
    for (int m = gw; m < S; m += NGW) {
        const f32x4* xr = (const f32x4*)(X + (size_t)m * DM) + F.lane;
        f32x4 v[8]; float s = 0.f;
#pragma unroll
        for (int j = 0; j < 8; ++j) { v[j] = xr[64 * j]; s += (v[j].x * v[j].x + v[j].y * v[j].y) + (v[j].z * v[j].z + v[j].w * v[j].w); }
        const float rs = 1.f / sqrtf(wave_sum(s) * (1.f / DM) + NORM_EPS);
        if (OUT_BF16) {
            u32x2* o8 = (u32x2*)((bf16_t*)O + (size_t)m * DM) + F.lane;
#pragma unroll
            for (int j = 0; j < 8; ++j) { u32x2 w; w.x = pk2(v[j].x * rs * gv[j].x, v[j].y * rs * gv[j].y); w.y = pk2(v[j].z * rs * gv[j].z, v[j].w * rs * gv[j].w); o8[64 * j] = w; }
        } else {
            f32x4* o = (f32x4*)((float*)O + (size_t)m * DM) + F.lane;
#pragma unroll
            for (int j = 0; j < 8; ++j) o[64 * j] = v[j] * rs * gv[j];
        }
    }
}

#define XB_TMO      128
#define XB_XCNT(j)  (256  + 64 * (j))
#define XB_XSUB(j)  (1280 + 64 * (j))
#define XB_XGEN(j)  (2304 + 64 * (j))
#define XB_TOP      3328
#define XB_TOPGEN   3392
#define XCD_BAR_WORDS 3456
#define XB_SPIN_CAP (1u << 18)

__device__ __forceinline__ unsigned xb_ld(unsigned* p)              { return __hip_atomic_load(p, __ATOMIC_RELAXED, __HIP_MEMORY_SCOPE_AGENT); }
__device__ __forceinline__ unsigned xb_add(unsigned* p, unsigned v) { return __hip_atomic_fetch_add(p, v, __ATOMIC_RELAXED, __HIP_MEMORY_SCOPE_AGENT); }
__device__ __forceinline__ unsigned xb_xcc_id() { return (unsigned)__builtin_amdgcn_s_getreg((3 << 11) | 20) & 0xFu; }
#define XB_SPIN(cond, bar) do { unsigned _sp = 0; while (cond) { __builtin_amdgcn_s_sleep(1); \
    if ((++_sp & 255u) == 0u) { if (xb_ld(&(bar)[XB_TMO])) break; if (_sp > XB_SPIN_CAP) { atomicAdd(&(bar)[XB_TMO], 1u); break; } } } } while (0)

struct XcdBarrier {
    unsigned* bar; unsigned x; unsigned G;
    volatile LAS unsigned* st;
};

__device__ __forceinline__ XcdBarrier xcd_barrier_post(unsigned* bar, volatile LAS unsigned* st, unsigned G, bool participate) {
    XcdBarrier b; b.bar = bar; b.x = xb_xcc_id(); b.st = st; b.G = G;
    if (participate && threadIdx.x == 0) (void)xb_add(&bar[XB_XCNT(b.x)], 1u);
    return b;
}
__device__ __forceinline__ void xcd_barrier_complete(unsigned* bar, unsigned x, unsigned& nloc, unsigned& nx, const unsigned G) {
    unsigned sum, cnt, mine, sp = 0u;
    for (;;) {
        sum = 0u; cnt = 0u; mine = 0u;
#pragma unroll
        for (unsigned j = 0; j < 16; ++j) { const unsigned c = xb_ld(&bar[XB_XCNT(j)]); sum += c; cnt += (c > 0u) ? 1u : 0u; mine = (j == x) ? c : mine; }
        if (sum == G) break;
        __builtin_amdgcn_s_sleep(1);
        if ((++sp & 255u) == 0u) { if (xb_ld(&bar[XB_TMO])) break; if (sp > XB_SPIN_CAP) { atomicAdd(&bar[XB_TMO], 1u); break; } }
    }
    nloc = mine > 0u ? mine : 1u; nx = cnt > 0u ? cnt : 1u;
}

__device__ __forceinline__ void xcd_barrier(const XcdBarrier& b) {
    asm volatile("s_waitcnt vmcnt(0)" ::: "memory");
    __syncthreads();
    if (threadIdx.x == 0) {
        unsigned* bar = b.bar;
        __builtin_amdgcn_s_waitcnt(0);
        unsigned nloc = b.st[0], nx = b.st[1];
        if (nloc == 0u) { xcd_barrier_complete(bar, b.x, nloc, nx, b.G); b.st[0] = nloc; b.st[1] = nx; }
        const unsigned old = xb_add(&bar[XB_XSUB(b.x)], 1u);
        const unsigned gen = old / nloc;
        if (old + 1u == (gen + 1u) * nloc) {
            __builtin_amdgcn_fence(__ATOMIC_RELEASE, "agent");
            asm volatile("s_waitcnt vmcnt(0)" ::: "memory");
            const unsigned og = xb_add(&bar[XB_TOP], 1u);
            const unsigned tg = og / nx;
            if (og + 1u == (tg + 1u) * nx) xb_add(&bar[XB_TOPGEN], 1u);
            else XB_SPIN(xb_ld(&bar[XB_TOPGEN]) == tg, bar);
            __builtin_amdgcn_fence(__ATOMIC_ACQUIRE, "agent");
            xb_add(&bar[XB_XGEN(b.x)], 1u);
            asm volatile("s_waitcnt vmcnt(0)" ::: "memory");
        } else {
            XB_SPIN(xb_ld(&bar[XB_XGEN(b.x)]) == gen, bar);
            __builtin_amdgcn_fence(__ATOMIC_ACQUIRE, "agent");
            asm volatile("s_waitcnt vmcnt(0)" ::: "memory");
        }
    }
    __syncthreads();
}

__device__ __forceinline__ void xcd_wait(unsigned* bar, unsigned k) {
    __syncthreads();
    if (threadIdx.x == 0) {
        XB_SPIN(xb_ld(&bar[XB_TOPGEN]) < k, bar);
        __builtin_amdgcn_fence(__ATOMIC_ACQUIRE, "agent");
        asm volatile("s_waitcnt vmcnt(0)" ::: "memory");
    }
    __syncthreads();
}
__device__ __forceinline__ void shadow_barrier(unsigned* ctr, unsigned target, bool arrive) {
    __syncthreads();
    if (threadIdx.x == 0) {
        __threadfence();
        if (arrive) __hip_atomic_fetch_add(ctr, 1u, __ATOMIC_RELAXED, __HIP_MEMORY_SCOPE_AGENT);
        while (__hip_atomic_load(ctr, __ATOMIC_RELAXED, __HIP_MEMORY_SCOPE_AGENT) < target) __builtin_amdgcn_s_sleep(2);
        __threadfence();
    }
    __syncthreads();
}
__device__ __forceinline__ float sigmoidf_(float x) { return 1.f / (1.f + __expf(-x)); }
__device__ __forceinline__ void rope_pair(bf16_t* p, int half, int i, float ang_rev) {
    const float sn = __builtin_amdgcn_sinf(ang_rev), cs = __builtin_amdgcn_cosf(ang_rev);
    const float x1 = bf2f(p[i]), x2 = bf2f(p[i + half]);
    p[i] = (bf16_t)f2bf(x1 * cs - x2 * sn); p[i + half] = (bf16_t)f2bf(x2 * cs + x1 * sn);
}
__device__ __forceinline__ float half_sum(float v, bool upper) {
    v += dppf<0xB1>(v); v += dppf<0x4E>(v); v += dppf<0x141>(v); v += dppf<0x140>(v);
    v += dppf_m<0x142, 0xA>(0.f, v);
    const float s31 = __builtin_bit_cast(float, __builtin_amdgcn_readlane(__builtin_bit_cast(int, v), 31));
    const float s63 = __builtin_bit_cast(float, __builtin_amdgcn_readlane(__builtin_bit_cast(int, v), 63));
    return upper ? s63 : s31;
}
__device__ __forceinline__ void prep_rwkv(Frame& F, const Args& a, int tile_lo, int tile_hi, int idx, int nwg) {
    bf16_t* U = (bf16_t*)(F.ws + WS_U);
    const float *mu_r = a.in[8], *mu_k = a.in[9], *mu_v = a.in[10], *mu_w = a.in[11], *mu_a = a.in[12];
    const float *w0 = a.in[14], *w2 = a.in[15], *a0 = a.in[16], *a2 = a.in[17], *k_k = a.in[19], *k_a = a.in[20], *r_k = a.in[21];
    float* Wd = (float*)(F.ws + WS_W); bf16_t* Ab = (bf16_t*)(F.ws + WS_A); bf16_t* Bb = (bf16_t*)(F.ws + WS_B); bf16_t* Kp = (bf16_t*)(F.ws + WS_KP);
    bf16_t* Rb = (bf16_t*)(F.ws + WS_R); bf16_t* Vb = (bf16_t*)(F.ws + WS_V);
    float* BR = (float*)(F.ws + WS_BR); float* KR = (float*)(F.ws + WS_KR); float* BON = (float*)(F.ws + WS_BON);
    LAS float* xw = (LAS float*)F.lds;
    LAS float* xa = xw + 16 * 64;
    constexpr int TT = 16;
    const int c0 = 2 * F.tid;
    const bool upper = (F.lane & 32) != 0; const int hd = 2 * F.wave + (upper ? 1 : 0);
    const f32x2 mr = *(const f32x2*)(mu_r + c0), mk = *(const f32x2*)(mu_k + c0), mv = *(const f32x2*)(mu_v + c0);
    const f32x2 w0v = *(const f32x2*)(w0 + c0), a0v = *(const f32x2*)(a0 + c0), kkv = *(const f32x2*)(k_k + c0), kav = *(const f32x2*)(k_a + c0), rkv = *(const f32x2*)(r_k + c0);
    for (int tile = tile_lo + idx; tile < tile_hi; tile += nwg) {
        const int t0 = tile * TT;
        __syncthreads();
        for (int e = F.tid; e < TT * 128; e += NTHR) {
            const int tt = e >> 7, d = e & 127, t = t0 + tt; const int col = (d < 64) ? (UWD + d) : (UAD + d - 64);
            const float cur = bf2f(U[(size_t)t * PWP + col]); const float prv = t > 0 ? bf2f(U[(size_t)(t - 1) * PWP + col]) : 0.f;
            const float mu = (d < 64) ? mu_w[d] : mu_a[d - 64];
            const float x = cur + (prv - cur) * mu;
            if (d < 64) xw[tt * 64 + d] = tanhf(x); else xa[tt * 64 + d - 64] = x;
        }
        __syncthreads();
        f32x2 lw[TT], la[TT];
#pragma unroll
        for (int tt = 0; tt < TT; ++tt) { lw[tt] = (f32x2){0.f, 0.f}; la[tt] = (f32x2){0.f, 0.f}; }
        for (int d = 0; d < 64; d += 4) {
            f32x2 ww[4], aa[4];
#pragma unroll
            for (int q = 0; q < 4; ++q) { ww[q] = *(const f32x2*)(w2 + (d + q) * 1024 + c0); aa[q] = *(const f32x2*)(a2 + (d + q) * 1024 + c0); }
#pragma unroll
            for (int tt = 0; tt < TT; ++tt) {
                const f32x4 xv = *(const LAS f32x4*)(xw + tt * 64 + d), av = *(const LAS f32x4*)(xa + tt * 64 + d);
#pragma unroll
                for (int q = 0; q < 4; ++q) { lw[tt] += ww[q] * xv[q]; la[tt] += aa[q] * av[q]; }
            }
        }
        LAS float* lwl = xa + 16 * 64;
        LAS float* lal = lwl + 16 * 1024;
#pragma unroll
        for (int tt = 0; tt < TT; ++tt) { *(LAS f32x2*)(lwl + tt * 1024 + c0) = lw[tt]; *(LAS f32x2*)(lal + tt * 1024 + c0) = la[tt]; }
        unsigned prr = 0u, prk = 0u, prv = 0u;
        if (t0 > 0) { const bf16_t* up = U + (size_t)(t0 - 1) * PWP; prr = *(const unsigned*)(up + URR + c0); prk = *(const unsigned*)(up + URK + c0); prv = *(const unsigned*)(up + URV + c0); }
#pragma unroll 2
        for (int tt = 0; tt < TT; ++tt) {
            const int t = t0 + tt; const bf16_t* ur = U + (size_t)t * PWP;
            const unsigned crr = *(const unsigned*)(ur + URR + c0), crk = *(const unsigned*)(ur + URK + c0), crv = *(const unsigned*)(ur + URV + c0);
            const f32x2 rc = {bflo(crr), bfhi(crr)}, kc = {bflo(crk), bfhi(crk)}, vc = {bflo(crv), bfhi(crv)};
            const f32x2 rp = {bflo(prr), bfhi(prr)}, kp = {bflo(prk), bfhi(prk)}, vp = {bflo(prv), bfhi(prv)};
            prr = crr; prk = crk; prv = crv;
            const f32x2 r = rc + (rp - rc) * mr, k = kc + (kp - kc) * mk, v = vc + (vp - vc) * mv;
            const f32x2 zw = w0v + *(const LAS f32x2*)(lwl + tt * 1024 + c0);
            const f32x2 za = a0v + *(const LAS f32x2*)(lal + tt * 1024 + c0);
            f32x2 decay, alpha;
#pragma unroll
            for (int e = 0; e < 2; ++e) {
                const float nz = -zw[e]; const float sp = fmaxf(nz, 0.f) + log1pf(__expf(-fabsf(nz)));
                decay[e] = __expf(-__expf(-sp - 0.5f)); alpha[e] = sigmoidf_(za[e]); }
            f32x2 kk = k * kkv;
            const float nrm = sqrtf(half_sum(kk.x * kk.x + kk.y * kk.y, upper));
            const float inv = 1.f / fmaxf(nrm, 1e-12f); kk = kk * inv;
            const f32x2 kmod = k * (1.f + (alpha - 1.f) * kav);
            const f32x2 bb = kk * alpha;
            const float br = half_sum(bb.x * r.x + bb.y * r.y, upper), kr = half_sum(kmod.x * r.x + kmod.y * r.y, upper);
            const float bon = half_sum(r.x * kmod.x * rkv.x + r.y * kmod.y * rkv.y, upper);
            const size_t o = (size_t)t * 1024 + c0;
            *(f32x2*)(Wd + o) = decay;
            *(unsigned*)(Ab + o) = pk2(-kk.x, -kk.y); *(unsigned*)(Bb + o) = pk2(bb.x, bb.y); *(unsigned*)(Kp + o) = pk2(kmod.x, kmod.y);
            *(unsigned*)(Rb + o) = pk2(r.x, r.y); *(unsigned*)(Vb + o) = pk2(v.x, v.y);
            if ((F.lane & 31) == 0) { BR[t * 16 + hd] = br; KR[t * 16 + hd] = kr; BON[t * 16 + hd] = bon; }
        }
    }
}
__device__ __forceinline__ void prep_rope(Frame& F, const Args& a, int idx, int nwg) {
    bf16_t* U = (bf16_t*)(F.ws + WS_U);
    constexpr int TT = 16;
    for (int tile = idx; tile < S / TT; tile += nwg) {
        const int t0 = tile * TT;
        for (int e = F.tid; e < TT * 232; e += NTHR) {
            const int tt = e / 232, p = e % 232, t = t0 + tt;
            bf16_t* ur = U + (size_t)t * PWP;
            int base, half, i; float invf;
            if (p < 160) { const int hd = p >> 4; i = p & 15; half = 16; base = (hd < 8) ? (UQ + 128 * hd) : (UK + 128 * (hd - 8)); invf = a.inv32[i]; }
            else { const int q = p - 160, hd = q >> 3; i = q & 7; half = 8; base = (hd < 8) ? (UQI + 64 * hd) : UKI; invf = a.inv16[i]; }
            const float ang = (float)t * invf;
            const double rev = (double)ang * 0.15915494309189535;
            const float fr = (float)(rev - rint(rev));
            rope_pair(ur + base, half, i, fr);
            if (p >= 224) { bf16_t* k2 = (bf16_t*)(F.ws + WS_KI2) + (size_t)t * 64; k2[i] = ur[UKI + i]; k2[i + 8] = ur[UKI + i + 8]; }
            if (p >= 128 && p < 160) { const int gg = (p >> 4) - 8; bf16_t* k2 = (bf16_t*)(F.ws + WS_KV2) + ((size_t)t * 2 + gg) * 256; k2[i] = ur[UK + 128 * gg + i]; k2[i + 16] = ur[UK + 128 * gg + i + 16]; }
        }
        for (int e = F.tid; e < TT * 224; e += NTHR) {
            const int tt = e / 224, r = e % 224, gg = r / 112, c2 = r % 112, t = t0 + tt;
            unsigned* dst = (unsigned*)((bf16_t*)(F.ws + WS_KV2) + ((size_t)t * 2 + gg) * 256);
            if (c2 < 48) dst[16 + c2] = ((const unsigned*)(U + (size_t)t * PWP + UK + 128 * gg + 32))[c2];
            else dst[64 + (c2 - 48)] = ((const unsigned*)(U + (size_t)t * PWP + UV + 128 * gg))[c2 - 48];
        }
        for (int e = F.tid; e < TT * 24; e += NTHR) {
            const int tt = e / 24, c2 = e % 24, t = t0 + tt;
            ((unsigned*)((bf16_t*)(F.ws + WS_KI2) + (size_t)t * 64 + 16))[c2] = ((const unsigned*)(U + (size_t)t * PWP + UKI + 16))[c2];
        }
    }
}

constexpr int RW_TB = 32, RW_REC = 384;
struct RwOps { f32x4 w, a, b, k, wr, vs; };
__device__ __forceinline__ void rwkv_scan(Frame& F, int wg, unsigned* shw, unsigned wait_target, int wait_blk) {
    const int h = wg >> 2, rq = wg & 3;
    const float* Wd = (const float*)(F.ws + WS_W); const bf16_t* Ab = (const bf16_t*)(F.ws + WS_A); const bf16_t* Bb = (const bf16_t*)(F.ws + WS_B); const bf16_t* Kp = (const bf16_t*)(F.ws + WS_KP);
    const bf16_t* Rb = (const bf16_t*)(F.ws + WS_R); const bf16_t* Vb = (const bf16_t*)(F.ws + WS_V);
    const float* BR = (const float*)(F.ws + WS_BR); const float* KR = (const float*)(F.ws + WS_KR);
    LAS float* buf = (LAS float*)F.lds;
    const bool loader = F.wave >= 4;
    const int lt = F.tid - 256, lstep = lt >> 3, part = lt & 7;
    struct LdRegs { f32x4 w0, w1; u32x4 a, b, k, r, v; float br, kr; };
    auto gload = [&](LdRegs& L, int blk) {
        const int t = blk * RW_TB + lstep; const size_t o = (size_t)t * 1024 + h * 64 + 8 * part;
        L.w0 = *(const f32x4*)(Wd + o); L.w1 = *(const f32x4*)(Wd + o + 4);
        L.a = *(const u32x4*)(Ab + o); L.b = *(const u32x4*)(Bb + o); L.k = *(const u32x4*)(Kp + o); L.r = *(const u32x4*)(Rb + o);
        if (part < 2) { L.v = *(const u32x4*)(Vb + (size_t)t * 1024 + h * 64 + 16 * rq + 8 * part); L.br = BR[t * 16 + h]; L.kr = KR[t * 16 + h]; }
    };
    auto lstore = [&](const LdRegs& L, int b) {
        LAS float* rec = buf + (b * RW_TB + lstep) * RW_REC;
        const u32x4 av = L.a, bv = L.b, kv = L.k, rv = L.r;
        f32x4 a_0 = {bflo(av.x), bfhi(av.x), bflo(av.y), bfhi(av.y)}, a_1 = {bflo(av.z), bfhi(av.z), bflo(av.w), bfhi(av.w)};
        f32x4 b_0 = {bflo(bv.x), bfhi(bv.x), bflo(bv.y), bfhi(bv.y)}, b_1 = {bflo(bv.z), bfhi(bv.z), bflo(bv.w), bfhi(bv.w)};
        f32x4 k_0 = {bflo(kv.x), bfhi(kv.x), bflo(kv.y), bfhi(kv.y)}, k_1 = {bflo(kv.z), bfhi(kv.z), bflo(kv.w), bfhi(kv.w)};
        f32x4 r_0 = {bflo(rv.x), bfhi(rv.x), bflo(rv.y), bfhi(rv.y)}, r_1 = {bflo(rv.z), bfhi(rv.z), bflo(rv.w), bfhi(rv.w)};
        *(LAS f32x4*)(rec + 8 * part) = L.w0; *(LAS f32x4*)(rec + 8 * part + 4) = L.w1;
        *(LAS f32x4*)(rec + 64 + 8 * part) = a_0; *(LAS f32x4*)(rec + 64 + 8 * part + 4) = a_1;
        *(LAS f32x4*)(rec + 128 + 8 * part) = b_0; *(LAS f32x4*)(rec + 128 + 8 * part + 4) = b_1;
        *(LAS f32x4*)(rec + 192 + 8 * part) = k_0; *(LAS f32x4*)(rec + 192 + 8 * part + 4) = k_1;
        *(LAS f32x4*)(rec + 256 + 8 * part) = L.w0 * r_0; *(LAS f32x4*)(rec + 256 + 8 * part + 4) = L.w1 * r_1;
        if (part < 2) { const u32x4 vv = L.v;
            const float v8[8] = {bflo(vv.x), bfhi(vv.x), bflo(vv.y), bfhi(vv.y), bflo(vv.z), bfhi(vv.z), bflo(vv.w), bfhi(vv.w)};
#pragma unroll
            for (int e = 0; e < 8; ++e) *(LAS f32x4*)(rec + 320 + (8 * part + e) * 4) = (f32x4){v8[e], v8[e] * L.kr, L.br, 0.f}; }
    };
    LdRegs L0, L1;
    __syncthreads();
    if (loader) { gload(L0, 0); lstore(L0, 0); gload(L0, 1); gload(L1, 2); }
    __syncthreads();
    const int rg = F.lane >> 4, j = F.lane & 15, row = 16 * rq + 4 * F.wave + rg;
    f32x4 st = {0.f, 0.f, 0.f, 0.f};
    unsigned char* Ub = F.ws + WS_U;
    const bool odd1 = (j & 1) != 0, odd2 = (j & 2) != 0;
    constexpr int NBLK = S / RW_TB;
    auto scan_block = [&](int blk) {
            const LAS float* rb = buf + ((blk & 1) * RW_TB) * RW_REC + 4 * j;
            const LAS float* rv_ = buf + ((blk & 1) * RW_TB) * RW_REC + 320 + (4 * F.wave + rg) * 4;
#define RW_LD(R, st_) do { const int off_ = (st_) * RW_REC; R.w = *(const LAS f32x4*)(rb + off_); R.a = *(const LAS f32x4*)(rb + off_ + 64); R.b = *(const LAS f32x4*)(rb + off_ + 128); \
                R.k = *(const LAS f32x4*)(rb + off_ + 192); R.wr = *(const LAS f32x4*)(rb + off_ + 256); R.vs = *(const LAS f32x4*)(rv_ + off_); } while (0)
            RwOps R[4];
            RW_LD(R[0], 0); RW_LD(R[1], 1); RW_LD(R[2], 2);
            for (int s4 = 0; s4 < RW_TB; s4 += 4) {
                float pz[4], u[4];
#pragma unroll
                for (int q = 0; q < 4; ++q) {
                    RW_LD(R[(q + 3) & 3], s4 + q + 3);
                    const RwOps& cur = R[q];
                    const f32x2 slo = {st.x, st.y}, shi = {st.z, st.w};
                    f32x2 ma = slo * (f32x2){cur.a.x, cur.a.y}; ma = __builtin_elementwise_fma(shi, (f32x2){cur.a.z, cur.a.w}, ma);
                    f32x2 mz = slo * (f32x2){cur.wr.x, cur.wr.y}; mz = __builtin_elementwise_fma(shi, (f32x2){cur.wr.z, cur.wr.w}, mz);
                    float psa = ma.x + ma.y; pz[q] = mz.x + mz.y;
                    const f32x2 vb = {cur.vs.x, cur.vs.x};
                    f32x2 tlo = (f32x2){cur.k.x, cur.k.y} * vb, thi = (f32x2){cur.k.z, cur.k.w} * vb;
                    tlo = __builtin_elementwise_fma(slo, (f32x2){cur.w.x, cur.w.y}, tlo); thi = __builtin_elementwise_fma(shi, (f32x2){cur.w.z, cur.w.w}, thi);
                    psa = red16(psa);
                    const f32x2 pb = {psa, psa};
                    tlo = __builtin_elementwise_fma((f32x2){cur.b.x, cur.b.y}, pb, tlo); thi = __builtin_elementwise_fma((f32x2){cur.b.z, cur.b.w}, pb, thi);
                    st = (f32x4){tlo.x, tlo.y, thi.x, thi.y};
                    u[q] = psa * cur.vs.z + cur.vs.y;
                }
                const float qa = (odd1 ? pz[1] : pz[0]) + dppf<0xB1>(odd1 ? pz[0] : pz[1]);
                const float qb = (odd1 ? pz[3] : pz[2]) + dppf<0xB1>(odd1 ? pz[2] : pz[3]);
                float r = (odd2 ? qb : qa) + dppf<0x4E>(odd2 ? qa : qb);
                r += dppf<0x124>(r); r += dppf<0x128>(r);
                const float us = odd2 ? (odd1 ? u[3] : u[2]) : (odd1 ? u[1] : u[0]);
                if (j < 4) { const int t = blk * RW_TB + s4 + j; ((float*)(Ub + (size_t)t * (PWP * 2) + URR * 2))[h * 64 + row] = r + us; }
            }
    };
    for (int blk = 0; blk < NBLK; blk += 2) {
        if (blk == wait_blk) xcd_wait(shw, wait_target);
        if (loader) { lstore(L0, 1); if (blk + 3 < NBLK) gload(L0, blk + 3); }
        else scan_block(blk);
        __syncthreads();
        if (loader) { if (blk + 2 < NBLK) { lstore(L1, 0); if (blk + 4 < NBLK) gload(L1, blk + 4); } }
        else scan_block(blk + 1);
        __syncthreads();
    }
}

constexpr int DSA_CAP = 640;
constexpr int DW_SC = 0, DW_IX = 4 * DSA_CAP * 4  , DW_P = DW_IX + 4 * DSA_CAP * 2  , DW_BYTES = DW_P + 4096  ;
static_assert(8 * DW_BYTES <= LDS_BYTES, "dsa lds");
typedef short v4i16_t __attribute__((ext_vector_type(4)));
__device__ __forceinline__ unsigned ukey(float f) { const unsigned b = __builtin_bit_cast(unsigned, f); return (b & 0x80000000u) ? ~b : (b | 0x80000000u); }
__device__ __forceinline__ float ukey_inv(unsigned k) { const unsigned b = (k & 0x80000000u) ? (k & 0x7fffffffu) : ~k; return __builtin_bit_cast(float, b); }
__device__ __forceinline__ int popc64(unsigned long long m) { return __builtin_popcountll(m); }
__device__ __forceinline__ int lanes_below(unsigned long long m) { return __builtin_amdgcn_mbcnt_hi((unsigned)(m >> 32), __builtin_amdgcn_mbcnt_lo((unsigned)m, 0u)); }

__device__ __forceinline__ float dsa_compact(const bool EXACT, LAS float* scl, LAS unsigned short* ixl, int n, int lane, int& ncnt) {
    float e[10]; unsigned x[10], uk[10];
#pragma unroll
    for (int i = 0; i < 10; ++i) { const int p = lane + 64 * i; const bool v = p < n; e[i] = v ? scl[p] : -INFINITY; x[i] = v ? ixl[p] : 0u; uk[i] = v ? ukey(e[i]) : 0u; }
    unsigned prefix = 0u;
    const int lowbit = EXACT ? 0 : 14;
    for (int bit = 31; bit >= lowbit; --bit) {
        const unsigned trial = prefix | (1u << bit); int c = 0;
#pragma unroll
        for (int i = 0; i < 10; ++i) c += popc64(__ballot(uk[i] >= trial));
        if (c >= 256) prefix = trial;
    }
    int need = 1 << 30;
    if (EXACT) { int cgt = 0;
#pragma unroll
        for (int i = 0; i < 10; ++i) cgt += popc64(__ballot(uk[i] > prefix));
        need = 256 - cgt; }
    int base = 0, tseen = 0;
#pragma unroll
    for (int i = 0; i < 10; ++i) {
        const bool gt = uk[i] > prefix, eq = uk[i] == prefix;
        const unsigned long long meq = __ballot(eq); const bool keep = gt || (eq && (tseen + lanes_below(meq)) < need); tseen += popc64(meq);
        const unsigned long long mk = __ballot(keep);
        if (keep) { const int pos = base + lanes_below(mk); scl[pos] = e[i]; ixl[pos] = (unsigned short)x[i]; }
        base += popc64(mk);
    }
    ncnt = base;
    return ukey_inv(prefix);
}

__device__ __forceinline__ void dsa_phase(Frame& F) {
    const bf16_t* U = (const bf16_t*)(F.ws + WS_U);
    const bf16_t* KI2 = (const bf16_t*)(F.ws + WS_KI2);
    const bf16_t* KV2 = (const bf16_t*)(F.ws + WS_KV2);
    bf16_t* MIX = (bf16_t*)(F.ws + WS_XN);
    unsigned* ctr = (unsigned*)(F.ws + WS_CTL);
    const int lane = F.lane, w = F.wave;
    LAS unsigned char* wl = F.lds + w * DW_BYTES;
    LAS float* scb = (LAS float*)(wl + DW_SC);
    LAS unsigned short* ixb = (LAS unsigned short*)(wl + DW_IX);
    LAS float* Pw = (LAS float*)(wl + DW_P);
    LAS unsigned short* Pb = (LAS unsigned short*)(wl + DW_P);
    LAS unsigned char* vst = wl + DW_SC;
    const int g5 = lane >> 5, n32 = lane & 31;
    for (;;) {
        unsigned item = 0u;
        if (lane == 0) item = atomicAdd(ctr, 1u);
        item = (unsigned)__builtin_amdgcn_readfirstlane((int)item);
        if (item >= 4096u) break;
        const int tq0 = (4095 - (int)item) * 4, ch = tq0 >> 6, nkb = ch + 1;
        bf16x8 afr[4];
        { const int rho = n32, b = rho >> 3, g = (rho >> 2) & 1, r = rho & 3, qq = 2 * g + (b >> 1), hh = 4 * (b & 1) + r;
          const bf16_t* src = U + (size_t)(tq0 + qq) * PWP + UQI + 64 * hh + 8 * g5;
#pragma unroll
          for (int ks = 0; ks < 4; ++ks) afr[ks] = *(const bf16x8*)(src + 16 * ks); }
        float wgt[16];
#pragma unroll
        for (int i = 0; i < 16; ++i) { const int qq = 2 * g5 + (i >> 3), hh = 4 * ((i >> 2) & 1) + (i & 3); wgt[i] = bf2f(U[(size_t)(tq0 + qq) * PWP + UWI + hh]) * 0.044194173824159216f; }
        int cnt0 = 0, cnt1 = 0, cnt2 = 0, cnt3 = 0;
        float tau0 = -INFINITY, tau1 = -INFINITY;
        const bf16_t* kbase = KI2 + (size_t)n32 * 64 + 8 * g5;
#define DSA_LOADB(B, kb_) do { _Pragma("unroll") for (int cb_ = 0; cb_ < 2; ++cb_) _Pragma("unroll") for (int ks_ = 0; ks_ < 4; ++ks_) \
            B[cb_][ks_] = *(const bf16x8*)(kbase + (size_t)(kb_) * 4096 + cb_ * 2048 + ks_ * 16); } while (0)
#define DSA_COMPACT_ALL(FIN, SCHED) do { _Pragma("unroll 1") for (int ql_ = 0; ql_ < 4; ++ql_) { \
            int c_ = (ql_ == 0) ? cnt0 : (ql_ == 1) ? cnt1 : (ql_ == 2) ? cnt2 : cnt3; \
            int mode_ = (FIN) ? (c_ > 256 ? 2 : 0) : ((c_ > 512) ? 1 : 0); \
            float thr_ = 0.f; bool did_ = false; \
            while (mode_) { int nc_; thr_ = dsa_compact(mode_ == 2, scb + ql_ * DSA_CAP, ixb + ql_ * DSA_CAP, c_, lane, nc_); c_ = nc_; did_ = true; mode_ = (mode_ == 1 && c_ > 512) ? 2 : 0; } \
            if (did_) { if (ql_ == 0) cnt0 = c_; else if (ql_ == 1) cnt1 = c_; else if (ql_ == 2) cnt2 = c_; else cnt3 = c_; \
                if (g5 == (ql_ >> 1)) { if (ql_ & 1) tau1 = thr_; else tau0 = thr_; } } } } while (0)
#define DSA_SCORE(B, kb_) do { \
            f32x16 acc0_, acc1_; \
            _Pragma("unroll") for (int i_ = 0; i_ < 16; ++i_) { acc0_[i_] = 0.f; acc1_[i_] = 0.f; } \
            _Pragma("unroll") for (int ks_ = 0; ks_ < 4; ++ks_) { acc0_ = __builtin_amdgcn_mfma_f32_32x32x16_bf16(afr[ks_], B[0][ks_], acc0_, 0, 0, 0); \
                acc1_ = __builtin_amdgcn_mfma_f32_32x32x16_bf16(afr[ks_], B[1][ks_], acc1_, 0, 0, 0); } \
            _Pragma("unroll") for (int cb_ = 0; cb_ < 2; ++cb_) { \
                float s0 = 0.f, s1 = 0.f; \
                _Pragma("unroll") for (int i_ = 0; i_ < 8; ++i_) { const float r0_ = __builtin_bit_cast(float, max(__builtin_bit_cast(int, cb_ ? acc1_[i_] : acc0_[i_]), 0)), r1_ = __builtin_bit_cast(float, max(__builtin_bit_cast(int, cb_ ? acc1_[8 + i_] : acc0_[8 + i_]), 0));     \
                    s0 = __builtin_fmaf(wgt[i_], r0_, s0); s1 = __builtin_fmaf(wgt[8 + i_], r1_, s1); } \
                const unsigned key_ = (unsigned)((kb_) * 64 + cb_ * 32 + n32); \
                const bool p0_ = s0 > tau0, p1_ = s1 > tau1; \
                const unsigned long long m0 = __ballot(p0_), m1 = __ballot(p1_); \
                const unsigned m0h = g5 ? (unsigned)(m0 >> 32) : (unsigned)m0, m1h = g5 ? (unsigned)(m1 >> 32) : (unsigned)m1; \
                const unsigned below = (1u << n32) - 1u; \
                if (p0_) { const int pos = (2 * g5) * DSA_CAP + (g5 ? cnt2 : cnt0) + __builtin_popcount(m0h & below); scb[pos] = s0; ixb[pos] = (unsigned short)key_; } \
                if (p1_) { const int pos = (2 * g5 + 1) * DSA_CAP + (g5 ? cnt3 : cnt1) + __builtin_popcount(m1h & below); scb[pos] = s1; ixb[pos] = (unsigned short)key_; } \
                cnt0 += __builtin_popcount((unsigned)m0); cnt2 += __builtin_popcount((unsigned)(m0 >> 32)); \
                cnt1 += __builtin_popcount((unsigned)m1); cnt3 += __builtin_popcount((unsigned)(m1 >> 32)); } } while (0)
        bf16x8 bA[2][4], bB[2][4];
        DSA_LOADB(bA, 0);
        int kb = 0;
        while (kb < nkb) {
            if (cnt0 > 512 || cnt1 > 512 || cnt2 > 512 || cnt3 > 512) DSA_COMPACT_ALL(false, false);
            const int rem = nkb - kb;
            if (rem == 1) { DSA_SCORE(bA, kb); kb += 1; break; }
            const int mx = max(max(cnt0, cnt1), max(cnt2, cnt3));
            int np = (DSA_CAP - mx) >> 7; np = min(np, rem >> 1);
            for (int i = 0; i < np; ++i, kb += 2) {
                DSA_LOADB(bB, kb + 1);
                DSA_SCORE(bA, kb);
                DSA_LOADB(bA, min(kb + 2, nkb - 1));
                DSA_SCORE(bB, kb + 1);
            }
        }
        DSA_COMPACT_ALL(true, false);
#undef DSA_LOADB
#undef DSA_SCORE
#undef DSA_COMPACT_ALL
        const int col = lane & 15, kq = lane >> 4;
        for (int ql = 0; ql < 4; ++ql) {
            const int t = tq0 + ql; const int nsel = (ql == 0) ? cnt0 : (ql == 1) ? cnt1 : (ql == 2) ? cnt2 : cnt3;
            const LAS unsigned short* ixl = ixb + ql * DSA_CAP;
            const int nch = nsel >> 5;
            u32x4 gr[8];
#define DSA_GATHER(c, g_, off_) do { _Pragma("unroll") for (int i = 0; i < 8; ++i) { const unsigned kidx = ixl[(c) * 32 + kq + 4 * i]; \
                gr[i] = *(const u32x4*)(KV2 + ((size_t)kidx * 2 + (g_)) * 256 + (off_) + 8 * col); } } while (0)
#define DSA_PUT() do { _Pragma("unroll") for (int i = 0; i < 8; ++i) *(LAS u32x4*)(vst + (kq + 4 * i) * 272 + col * 16) = gr[i]; } while (0)
            for (int g = 0; g < 2; ++g) {
                bf16x8 qf[4];
#pragma unroll
                for (int ks = 0; ks < 4; ++ks) { if (col < 4) qf[ks] = *(const bf16x8*)(U + (size_t)t * PWP + UQ + 128 * (4 * g + col) + 32 * ks + 8 * kq); else qf[ks] = (bf16x8){0, 0, 0, 0, 0, 0, 0, 0}; }
                DSA_GATHER(0, g, 0);
                for (int c = 0; c < nch; ++c) {
                    DSA_PUT();
                    if (c + 1 < nch) DSA_GATHER(c + 1, g, 0); else DSA_GATHER(0, g, 128);
#pragma unroll
                    for (int kb2 = 0; kb2 < 2; ++kb2) {
                        f32x4 a4 = {0.f, 0.f, 0.f, 0.f};
#pragma unroll
                        for (int ks = 0; ks < 4; ++ks) { const bf16x8 kf = *(const LAS bf16x8*)(vst + (16 * kb2 + col) * 272 + (32 * ks + 8 * kq) * 2); a4 = __builtin_amdgcn_mfma_f32_16x16x32_bf16(kf, qf[ks], a4, 0, 0, 0); }
                        if (col < 4) {
#pragma unroll
                            for (int i = 0; i < 4; ++i) Pw[(32 * c + 16 * kb2 + 4 * kq + i) * 4 + col] = a4[i] * 0.08838834764831845f;
                        }
                    }
                }
                f32x4 sv[4]; f32x4 mx = {-INFINITY, -INFINITY, -INFINITY, -INFINITY};
#pragma unroll
                for (int jj = 0; jj < 4; ++jj) { if (lane + 64 * jj < nsel) sv[jj] = *(const LAS f32x4*)(Pw + (lane + 64 * jj) * 4); else sv[jj] = (f32x4){-INFINITY, -INFINITY, -INFINITY, -INFINITY};
#pragma unroll
                    for (int hh = 0; hh < 4; ++hh) mx[hh] = fmaxf(mx[hh], sv[jj][hh]); }
                f32x4 sm = {0.f, 0.f, 0.f, 0.f};
#pragma unroll
                for (int hh = 0; hh < 4; ++hh) { mx[hh] = wave_max(mx[hh]);
#pragma unroll
                    for (int jj = 0; jj < 4; ++jj) { sv[jj][hh] = __expf(sv[jj][hh] - mx[hh]); sm[hh] += sv[jj][hh]; }
                    sm[hh] = 1.f / wave_sum(sm[hh]); }
#pragma unroll
                for (int jj = 0; jj < 4; ++jj)
#pragma unroll
                    for (int hh = 0; hh < 4; ++hh) Pb[hh * 256 + lane + 64 * jj] = (unsigned short)f2bf(sv[jj][hh] * sm[hh]);
                f32x4 oacc[8];
#pragma unroll
                for (int db = 0; db < 8; ++db) oacc[db] = (f32x4){0.f, 0.f, 0.f, 0.f};
                const int tq = col >> 2, tp = col & 3;
                for (int c = 0; c < nch; ++c) {
                    DSA_PUT();
                    if (c + 1 < nch) DSA_GATHER(c + 1, g, 128);
                    bf16x8 pf = (bf16x8){0, 0, 0, 0, 0, 0, 0, 0};
                    if (col < 4) pf = *(const LAS bf16x8*)(Pb + col * 256 + 32 * c + 8 * kq);
                    const LAS unsigned char* vrow = vst + (8 * kq + tq) * 272 + 8 * tp;
#pragma unroll
                    for (int db = 0; db < 8; ++db) {
                        const v4i16_t lo = __builtin_amdgcn_ds_read_tr16_b64_v4i16((LAS v4i16_t*)(vrow + 32 * db));
                        const v4i16_t hi = __builtin_amdgcn_ds_read_tr16_b64_v4i16((LAS v4i16_t*)(vrow + 4 * 272 + 32 * db));
                        const bf16x8 vf = {lo[0], lo[1], lo[2], lo[3], hi[0], hi[1], hi[2], hi[3]};
                        oacc[db] = __builtin_amdgcn_mfma_f32_16x16x32_bf16(vf, pf, oacc[db], 0, 0, 0);
                    }
                }
                if (col < 4) {
#pragma unroll
                    for (int db = 0; db < 8; ++db) { u32x2 o; o.x = pk2(oacc[db][0], oacc[db][1]); o.y = pk2(oacc[db][2], oacc[db][3]);
                        *(u32x2*)(MIX + (size_t)t * DM + 128 * (4 * g + col) + 16 * db + 4 * kq) = o; }
                }
            }
#undef DSA_GATHER
#undef DSA_PUT
        }
    }
}

__device__ __forceinline__ void post_phase(Frame& F, const Args& a) {
    const bf16_t* U = (const bf16_t*)(F.ws + WS_U);
    bf16_t* MIX = (bf16_t*)(F.ws + WS_XN);
    const bf16_t* Vb = (const bf16_t*)(F.ws + WS_V); const float* BON = (const float*)(F.ws + WS_BON);
    const float *mu_g = a.in[13], *g2 = a.in[18], *gng = a.in[22], *gnb = a.in[23];
    LAS float* xg = (LAS float*)F.lds;
    constexpr int TT = 16;
    const int c0 = 2 * F.tid;
    const bool upper = (F.lane & 32) != 0; const int hd = 2 * F.wave + (upper ? 1 : 0);
    const f32x2 ggv = *(const f32x2*)(gng + c0), gbv = *(const f32x2*)(gnb + c0);
    for (int tile = F.bid; tile < S / TT; tile += F.G) {
        const int t0 = tile * TT;
        __syncthreads();
        for (int e = F.tid; e < TT * 64; e += NTHR) {
            const int tt = e >> 6, d = e & 63, t = t0 + tt;
            const float cur = bf2f(U[(size_t)t * PWP + UGD + d]); const float prv = t > 0 ? bf2f(U[(size_t)(t - 1) * PWP + UGD + d]) : 0.f;
            xg[tt * 64 + d] = sigmoidf_(cur + (prv - cur) * mu_g[d]);
        }
        __syncthreads();
        f32x2 gg[TT];
#pragma unroll
        for (int tt = 0; tt < TT; ++tt) gg[tt] = (f32x2){0.f, 0.f};
        for (int d = 0; d < 64; d += 4) {
            f32x2 wv[4];
#pragma unroll
            for (int q = 0; q < 4; ++q) wv[q] = *(const f32x2*)(g2 + (d + q) * 1024 + c0);
#pragma unroll
            for (int tt = 0; tt < TT; ++tt) { const f32x4 xv = *(const LAS f32x4*)(xg + tt * 64 + d);
#pragma unroll
                for (int q = 0; q < 4; ++q) gg[tt] += wv[q] * xv[q]; }
        }
        LAS float* gl = xg + 16 * 64;
#pragma unroll
        for (int tt = 0; tt < TT; ++tt) *(LAS f32x2*)(gl + tt * 1024 + c0) = gg[tt];
#pragma unroll 4
        for (int tt = 0; tt < TT; ++tt) {
            const int t = t0 + tt; const float* yrow = (const float*)((const unsigned char*)U + (size_t)t * (PWP * 2) + URR * 2);
            const f32x2 y = *(const f32x2*)(yrow + c0);
            const unsigned vq = *(const unsigned*)(Vb + (size_t)t * 1024 + c0);
            const float mean = half_sum(y.x + y.y, upper) * (1.f / 64.f); const f32x2 dlt = y - mean;
            const float var = half_sum(dlt.x * dlt.x + dlt.y * dlt.y, upper) * (1.f / 64.f);
            f32x2 o = dlt * (1.f / sqrtf(var + GN_EPS)) * ggv + gbv;
            o += (f32x2){bflo(vq), bfhi(vq)} * BON[t * 16 + hd];
            o = o * *(const LAS f32x2*)(gl + tt * 1024 + c0);
            *(unsigned*)(MIX + (size_t)t * DM + 1024 + c0) = pk2(o.x, o.y);
        }
    }
}

__device__ __forceinline__ void light_grid_barrier(unsigned* ctr, unsigned target) {
    __syncthreads();
    if (threadIdx.x == 0) {
        __threadfence();
        __hip_atomic_fetch_add(ctr, 1u, __ATOMIC_RELAXED, __HIP_MEMORY_SCOPE_AGENT);
        while (__hip_atomic_load(ctr, __ATOMIC_RELAXED, __HIP_MEMORY_SCOPE_AGENT) < target) __builtin_amdgcn_s_sleep(2);
        __threadfence();
    }
    __syncthreads();
}
constexpr int NPHASE = 13;
__global__ void __launch_bounds__(NTHR, 2) fwd_kernel(Args a) {
    extern __shared__ __attribute__((aligned(16))) unsigned char lds_raw[];
    Frame F; F.lds = (LAS unsigned char*)lds_raw; F.tid = threadIdx.x; F.lane = F.tid & 63; F.wave = __builtin_amdgcn_readfirstlane(F.tid >> 6); F.G = gridDim.x; F.bid = blockIdx.x; F.ws = a.ws;
    cg::grid_group grid = cg::this_grid();
    volatile LAS unsigned* xst = (volatile LAS unsigned*)(F.lds + LDS_BYTES - 64);
    if (F.tid < 4) xst[F.tid] = 0u;
    __syncthreads();
    const XcdBarrier xbar = xcd_barrier_post((unsigned*)(F.ws + WS_CTL + 4096), xst, (unsigned)F.G, true);
    const bool is_scan = (F.bid & 7) < 2;
    const int scan_idx = (F.bid >> 3) * 2 + (F.bid & 7), sh_idx = (F.bid >> 3) * 6 + ((F.bid & 7) - 2);
    const XcdBarrier xbar2 = xcd_barrier_post((unsigned*)(F.ws + WS_CTL + 20480), xst + 2, (unsigned)(F.G - 64), !is_scan);
    const int lo = a.ph_lo, hi = a.ph_hi;
#define IN(k) (lo <= (k) && (k) < hi)
    unsigned nbar = 0; unsigned* barw = (unsigned*)(F.ws + WS_CTL + 256);
    if (lo < 0) grid.sync();
#define SEAM(k) do { if (IN(k) && IN((k) + 1)) xcd_barrier(xbar); } while (0)
    bf16_t* ACT = (bf16_t*)(F.ws + WS_U); bf16_t* XN = (bf16_t*)(F.ws + WS_XN);
    bf16_t* WGU = (bf16_t*)(F.ws + WS_WB); bf16_t* WDN = (bf16_t*)(F.ws + WS_WB2); bf16_t* WOUT = (bf16_t*)(F.ws + WS_WOUT);
    if (IN(0)) {
        if (F.bid == 0 && F.tid == 0) *(unsigned*)(F.ws + WS_CTL) = 0u;
        convert_weight<1>(F, a.in[2], a.in[3], DM, FF, 2 * FF, WGU);
        convert_weight<0>(F, a.in[4], nullptr, FF, DM, DM, WDN);
        rmsnorm_rows<true>(F, a.in[0], a.in[1], XN);
    }
    SEAM(0);
    if (IN(1)) { pg8::Gemm g{XN, WGU, S, 2 * FF, DM}; pg8::StaticOrder So; So.init(S, 2 * FF, F.G, F.bid); pg8::EpiSwiglu E{ACT, FF}; pg8::gemm_phase(F.lds, g, So, E); }
#if defined(PROBE_REPG)
    grid.sync();
    if (IN(1)) { pg8::Gemm g{XN, WGU, S, 2 * FF, DM}; pg8::StaticOrder So; So.init(S, 2 * FF, F.G, F.bid); pg8::EpiSwiglu E{ACT, FF}; pg8::gemm_phase(F.lds, g, So, E); }
#endif
    SEAM(1);
    if (IN(2)) { pg8::Gemm g{ACT, WDN, S, DM, FF}; pg8::StaticOrder So; So.init(S, DM, F.G, F.bid); pg8::EpiResF32 E{a.in[0], a.out, DM, 0.5f}; pg8::gemm_phase(F.lds, g, So, E); }
    SEAM(2);
    if (IN(3)) {
        convert_weight<2>(F, a.in[6], nullptr, DM, PW, NG1, (bf16_t*)(F.ws + WS_KV2));
        convert_weight<3>(F, a.in[6], nullptr, DM, PW, NG2, (bf16_t*)(F.ws + WS_WIN2));
        convert_weight<0>(F, a.in[7], nullptr, DM, DM, DM, WOUT);
        rmsnorm_rows<true>(F, a.out, a.in[5], XN);
    }
#if defined(PROBE_REPC)
    grid.sync();
    if (IN(3)) {
        convert_weight<2>(F, a.in[6], nullptr, DM, PW, NG1, (bf16_t*)(F.ws + WS_KV2));
        convert_weight<3>(F, a.in[6], nullptr, DM, PW, NG2, (bf16_t*)(F.ws + WS_WIN2));
        convert_weight<0>(F, a.in[7], nullptr, DM, DM, DM, WOUT);
        rmsnorm_rows<true>(F, a.out, a.in[5], XN);
    }
#endif
    SEAM(3);
    constexpr int M1 = 16 * 256, T1 = M1 / 16;
    constexpr int NG1A = 3072;
    if (IN(4)) {
        const bf16_t* WIN1 = (const bf16_t*)(F.ws + WS_KV2);
        if (F.bid < 192) { pg8::Gemm g{XN, WIN1, M1, NG1A, DM}; pg8::StaticOrder So; So.init(M1, NG1A, 192, F.bid); pg8::EpiBf16 E{ACT, PWP}; pg8::gemm_phase(F.lds, g, So, E); }
        else { pg8::Gemm g{XN, WIN1 + (size_t)NG1A * DM, S, 256, DM}; pg8::StaticOrder So; So.init(S, 256, F.G - 192, F.bid - 192); pg8::EpiBf16 E{ACT + NG1A, PWP}; pg8::gemm_phase(F.lds, g, So, E); }
    }
    SEAM(4);
    if (IN(5)) prep_rwkv(F, a, 0, T1, F.bid, F.G);
    SEAM(5);
    if (IN(6)) {
        unsigned* shw = (unsigned*)(F.ws + WS_CTL + 20480); const int nsh = F.G - 64;
        if (is_scan) { rwkv_scan(F, scan_idx, shw, 2u, (M1 / RW_TB - 4) & ~1); xcd_wait(shw, 4u); }
        else {
            { pg8::Gemm g{XN + (size_t)M1 * DM, (const bf16_t*)(F.ws + WS_KV2), S - M1, NG1A, DM}; pg8::StaticOrder So; So.init(S - M1, NG1A, nsh, sh_idx); pg8::EpiBf16 E{ACT + (size_t)M1 * PWP, PWP}; pg8::gemm_phase(F.lds, g, So, E); }
            xcd_barrier(xbar2);
            prep_rwkv(F, a, T1, S / 16, sh_idx, nsh);
            xcd_barrier(xbar2);
            { pg8::Gemm g{XN, (const bf16_t*)(F.ws + WS_WIN2), S, NG2, DM}; pg8::StaticOrder So; So.init(S, NG2, nsh, sh_idx); pg8::EpiBf16 E{ACT + NG1, PWP}; pg8::gemm_phase(F.lds, g, So, E); }
            xcd_barrier(xbar2);
            prep_rope(F, a, sh_idx, nsh);
            xcd_barrier(xbar2);
        }
        dsa_phase(F);
    }
#if defined(PROBE_REP6)
    grid.sync(); if (F.bid == 0 && F.tid == 0) *(unsigned*)(F.ws + WS_CTL) = 0u; grid.sync();
#if PROBE_REP6 == 1
    if (IN(6)) { if (F.bid < 64) rwkv_scan(F, F.bid); dsa_phase(F); }
#elif PROBE_REP6 == 2
    if (IN(6)) { if (F.bid < 64) rwkv_scan(F, F.bid); }
#elif PROBE_REP6 == 3
    if (IN(6)) { dsa_phase(F); }
#else
    if (IN(6)) { dsa_phase(F); }
#endif
#endif
    SEAM(6);
    if (IN(7)) post_phase(F, a);
    SEAM(7);
    if (IN(8)) { pg8::Gemm g{XN, WOUT, S, DM, DM}; pg8::StaticOrder So; So.init(S, DM, F.G, F.bid); pg8::EpiResF32 E{a.out, a.out, DM, 1.0f}; pg8::gemm_phase(F.lds, g, So, E); }
    SEAM(8);
    if (IN(9)) {
        convert_weight<1>(F, a.in[25], a.in[26], DM, FF, 2 * FF, WGU);
        convert_weight<0>(F, a.in[27], nullptr, FF, DM, DM, WDN);
        rmsnorm_rows<true>(F, a.out, a.in[24], XN);
    }
    SEAM(9);
    if (IN(10)) { pg8::Gemm g{XN, WGU, S, 2 * FF, DM}; pg8::StaticOrder So; So.init(S, 2 * FF, F.G, F.bid); pg8::EpiSwiglu E{ACT, FF}; pg8::gemm_phase(F.lds, g, So, E); }
    SEAM(10);
    if (IN(11)) { pg8::Gemm g{ACT, WDN, S, DM, FF}; pg8::StaticOrder So; So.init(S, DM, F.G, F.bid); pg8::EpiResF32 E{a.out, a.out, DM, 0.5f}; pg8::gemm_phase(F.lds, g, So, E); }
    SEAM(11);
    if (IN(12)) rmsnorm_rows<false>(F, a.out, a.in[28], a.out);
#undef IN
#undef SEAM
}


#ifndef MK_MULTI
#define MK_MULTI 0
#endif
extern "C" void kernel_launch(void* const* d_in, const int* in_sizes, int n_in, void* d_out, int out_size, void* d_ws, size_t ws_size, hipStream_t stream) {
    static int grid = 0;
    if (grid == 0) {
        if (n_in != 29 || out_size != S * DM || ws_size < WS_END) { fprintf(stderr, "kernel_launch: unexpected shapes n_in %d out %d ws %zu\n", n_in, out_size, ws_size); grid = -1; return; }
        int dev = 0, cus = 0, per_cu = 0;
        (void)hipGetDevice(&dev); (void)hipDeviceGetAttribute(&cus, hipDeviceAttributeMultiprocessorCount, dev);
        if (hipFuncSetAttribute((const void*)fwd_kernel, hipFuncAttributeMaxDynamicSharedMemorySize, LDS_BYTES) != hipSuccess) { fprintf(stderr, "kernel_launch: hipFuncSetAttribute failed\n"); grid = -1; return; }
        (void)hipOccupancyMaxActiveBlocksPerMultiprocessor(&per_cu, (const void*)fwd_kernel, NTHR, LDS_BYTES);
        if (per_cu < 1) per_cu = 1;
        (void)hipGetLastError();
        grid = cus * per_cu;
        fprintf(stderr, "kernel_launch: grid %d (cus %d per_cu %d)\n", grid, cus, per_cu);
    }
    if (grid < 0) return;
    (void)hipMemsetAsync((char*)d_ws + WS_CTL, 0, 65536, stream);
    Args a{};
    for (int i = 0; i < 29; ++i) a.in[i] = (const float*)d_in[i];
    a.out = (float*)d_out; a.ws = (unsigned char*)d_ws;
    for (int i = 0; i < 16; ++i) a.inv32[i] = powf(500000.0f, -((float)i * 2.0f / 32.0f));
    for (int i = 0; i < 8; ++i) a.inv16[i] = powf(500000.0f, -((float)i * 2.0f / 16.0f));
#if MK_MULTI
    for (int p = 0; p < NPHASE; ++p) { a.ph_lo = p; a.ph_hi = p + 1; hipLaunchKernelGGL(fwd_kernel, dim3(grid), dim3(NTHR), LDS_BYTES, stream, a); }
#else
    a.ph_lo = 0; a.ph_hi = NPHASE;
    void* args[] = {&a};
    hipError_t e = hipLaunchCooperativeKernel((const void*)fwd_kernel, dim3(grid), dim3(NTHR), args, LDS_BYTES, stream);
    if (e != hipSuccess) fprintf(stderr, "cooperative launch failed: %s (grid %d)\n", hipGetErrorString(e), grid);
#endif
}
```
